# Optimizing an MI355X kernel written in HIP

```python
import jax, jax.numpy as jnp
from jax import lax
import numpy as np

D_MODEL = 1024
BATCH = 8
SEQ = 4096
DEPTH = 1

GRID_W = 64
CTX_LEN = 256
HEAD_DIM = 64
A_HEADS = 8
A_KV_HEADS = 2
A_WINDOW = 128
A_BLOCK = 128
B_HEADS = 8
NA_MAX_KH = 8
NA_KW = 16
NA_ROW_BLOCK = 2
A_WIDTH = A_HEADS * HEAD_DIM
A_KV_WIDTH = A_KV_HEADS * HEAD_DIM
B_WIDTH = B_HEADS * HEAD_DIM
MIX_WIDTH = A_WIDTH + B_WIDTH
IN_COLS = A_WIDTH + 2 * A_KV_WIDTH + 3 * B_WIDTH
FFN_HIDDEN = -(-8 * D_MODEL // (3 * 256)) * 256
N_MOD = 6
ROPE_BASE = 10000.0
EPS = 1e-6

kernel_name = "hybrid_window_neighbourhood_dit_block"


def _rms_norm(x, g):
    xf = x.astype(jnp.float32)
    y = xf * lax.rsqrt(jnp.mean(xf * xf, axis=-1, keepdims=True) + EPS)
    return (y * g.astype(jnp.float32)).astype(x.dtype)


def _modulate(h, shift, scale):
    return h * (1 + scale) + shift


def _axial_rope(x, rows, cols):
    half = HEAD_DIM // 2
    quarter = half // 2
    inv_freq = 1.0 / (ROPE_BASE ** (jnp.arange(quarter, dtype=jnp.float32) / quarter))

    def rot(xh, pos):
        ang = pos.astype(jnp.float32)[:, None] * inv_freq[None, :]
        cos = jnp.cos(ang)[None, :, None, :]
        sin = jnp.sin(ang)[None, :, None, :]
        x1 = xh[..., :quarter].astype(jnp.float32)
        x2 = xh[..., quarter:].astype(jnp.float32)
        return jnp.concatenate([x1 * cos - x2 * sin, x1 * sin + x2 * cos], axis=-1)

    out = jnp.concatenate([rot(x[..., :half], rows), rot(x[..., half:], cols)], axis=-1)
    return out.astype(x.dtype)


def _in_proj(h, w_in):
    B, L, _ = h.shape
    p = h @ w_in
    offs = np.cumsum([A_WIDTH, A_KV_WIDTH, A_KV_WIDTH, B_WIDTH, B_WIDTH])
    q_a, k_a, v_a, q_b, k_b, v_b = jnp.split(p, offs, axis=-1)
    hd = lambda t, n: t.reshape(B, L, n, HEAD_DIM)
    return (hd(q_a, A_HEADS), hd(k_a, A_KV_HEADS), hd(v_a, A_KV_HEADS),
            hd(q_b, B_HEADS), hd(k_b, B_HEADS), hd(v_b, B_HEADS))


def _band_mask(S):
    nb = S // A_BLOCK
    span = A_BLOCK + 2 * A_WINDOW
    qpos = np.arange(nb)[:, None, None] * A_BLOCK + np.arange(A_BLOCK)[None, :, None]
    kpos = np.arange(nb)[:, None, None] * A_BLOCK - A_WINDOW + np.arange(span)[None, None, :]
    return (np.abs(kpos - qpos) <= A_WINDOW) & (kpos >= 0) & (kpos < S)


def _window_gqa_latent(q, k, v, k_ctx, v_ctx, sink):
    B, S = q.shape[:2]
    nb = S // A_BLOCK
    G = A_HEADS // A_KV_HEADS
    n_side = A_WINDOW // A_BLOCK
    scale = HEAD_DIM ** -0.5
    pad = ((0, 0), (A_WINDOW, A_WINDOW), (0, 0), (0, 0))
    kp = jnp.pad(k, pad).reshape(B, nb + 2 * n_side, A_BLOCK, A_KV_HEADS, HEAD_DIM)
    vp = jnp.pad(v, pad).reshape(B, nb + 2 * n_side, A_BLOCK, A_KV_HEADS, HEAD_DIM)
    kb = jnp.concatenate([kp[:, o:o + nb] for o in range(2 * n_side + 1)], axis=2)
    vb = jnp.concatenate([vp[:, o:o + nb] for o in range(2 * n_side + 1)], axis=2)
    span = kb.shape[2]
    qb = q.reshape(B, nb, A_BLOCK, A_KV_HEADS, G, HEAD_DIM)
    mask = jnp.asarray(_band_mask(S))[:, None, None]
    s_loc = jnp.einsum('bnqkgd,bnjkd->bnkgqj', qb, kb).astype(jnp.float32) * scale
    s_loc = jnp.where(mask, s_loc, -jnp.inf)
    s_ctx = jnp.einsum('bnqkgd,bjkd->bnkgqj', qb, k_ctx).astype(jnp.float32) * scale
    sink_col = jnp.broadcast_to(sink.astype(jnp.float32).reshape(1, 1, A_KV_HEADS, G, 1, 1),
                                s_loc.shape[:-1] + (1,))
    p = jax.nn.softmax(jnp.concatenate([s_loc, s_ctx, sink_col], axis=-1), axis=-1)
    L = k_ctx.shape[1]
    p_loc = p[..., :span].astype(v.dtype)
    p_ctx = p[..., span:span + L].astype(v.dtype)
    o = (jnp.einsum('bnkgqj,bnjkd->bnqkgd', p_loc, vb)
         + jnp.einsum('bnkgqj,bjkd->bnqkgd', p_ctx, v_ctx))
    return o.reshape(B, S, A_WIDTH)


def _na_pattern(rows):
    kh = min(NA_MAX_KH, rows)
    n_blk = rows // NA_ROW_BLOCK
    n_kr = min(NA_ROW_BLOCK + kh - 1, rows)
    r0 = np.arange(n_blk) * NA_ROW_BLOCK
    row_start = lambda r: np.clip(r - kh // 2, 0, rows - kh)
    k_start = np.minimum(row_start(r0), rows - n_kr)
    key_rows = k_start[:, None] + np.arange(n_kr)[None, :]
    qi = np.arange(NA_ROW_BLOCK * GRID_W)
    q_r = r0[:, None] + qi[None, :] // GRID_W
    q_c = qi % GRID_W
    kj = np.arange(n_kr * GRID_W)
    k_r = key_rows[:, kj // GRID_W]
    k_c = kj % GRID_W
    rs = row_start(q_r)
    cs = np.clip(q_c - NA_KW // 2, 0, GRID_W - NA_KW)
    row_ok = (k_r[:, None, :] >= rs[:, :, None]) & (k_r[:, None, :] < rs[:, :, None] + kh)
    col_ok = (k_c[None, :] >= cs[:, None]) & (k_c[None, :] < cs[:, None] + NA_KW)
    mask = row_ok & col_ok[None]
    dr = np.clip(k_r[:, None, :] - q_r[:, :, None] + NA_MAX_KH - 1, 0, 2 * NA_MAX_KH - 2)
    dc = np.broadcast_to(np.clip(k_c[None, :] - q_c[:, None] + NA_KW - 1, 0, 2 * NA_KW - 2)[None],
                         mask.shape)
    return key_rows, mask, dr, dc


def _neighbourhood_latent(q, k, v, k_ctx, v_ctx, rpb):
    B, S = q.shape[:2]
    rows = S // GRID_W
    key_rows, mask, dr, dc = _na_pattern(rows)
    n_blk, n_kr = key_rows.shape
    scale = HEAD_DIM ** -0.5
    idx = jnp.asarray(key_rows)
    kg = k.reshape(B, rows, GRID_W, B_HEADS, HEAD_DIM)[:, idx].reshape(
        B, n_blk, n_kr * GRID_W, B_HEADS, HEAD_DIM)
    vg = v.reshape(B, rows, GRID_W, B_HEADS, HEAD_DIM)[:, idx].reshape(
        B, n_blk, n_kr * GRID_W, B_HEADS, HEAD_DIM)
    qb = q.reshape(B, n_blk, NA_ROW_BLOCK * GRID_W, B_HEADS, HEAD_DIM)
    bias = jnp.transpose(rpb[:, jnp.asarray(dr), jnp.asarray(dc)], (1, 0, 2, 3)).astype(jnp.float32)
    s_loc = jnp.einsum('bnqhd,bnjhd->bnhqj', qb, kg).astype(jnp.float32) * scale + bias
    s_loc = jnp.where(jnp.asarray(mask)[:, None], s_loc, -jnp.inf)
    s_ctx = jnp.einsum('bnqhd,bjhd->bnhqj', qb, k_ctx).astype(jnp.float32) * scale
    p = jax.nn.softmax(jnp.concatenate([s_loc, s_ctx], axis=-1), axis=-1)
    kb_len = kg.shape[2]
    p_loc = p[..., :kb_len].astype(v.dtype)
    p_ctx = p[..., kb_len:].astype(v.dtype)
    o = (jnp.einsum('bnhqj,bnjhd->bnqhd', p_loc, vg)
         + jnp.einsum('bnhqj,bjhd->bnqhd', p_ctx, v_ctx))
    return o.reshape(B, S, B_WIDTH)


def _ctx_self_attention(q, k, v, n_kv, sink=None):
    B, L, H, _ = q.shape
    G = H // n_kv
    qg = q.reshape(B, L, n_kv, G, HEAD_DIM)
    s = jnp.einsum('blkgd,bjkd->bkglj', qg, k).astype(jnp.float32) * HEAD_DIM ** -0.5
    if sink is not None:
        sink_col = jnp.broadcast_to(sink.astype(jnp.float32).reshape(1, n_kv, G, 1, 1), s.shape[:-1] + (1,))
        s = jnp.concatenate([s, sink_col], axis=-1)
    p = jax.nn.softmax(s, axis=-1)[..., :L].astype(v.dtype)
    o = jnp.einsum('bkglj,bjkd->blkgd', p, v)
    return o.reshape(B, L, H * HEAD_DIM)


def _merge(o_a, o_b, g_a, g_b, w_out):
    return jnp.concatenate([_rms_norm(o_a, g_a), _rms_norm(o_b, g_b)], axis=-1) @ w_out


def _swiglu(h, w_gate, w_up, w_down):
    return (jax.nn.silu(h @ w_gate) * (h @ w_up)) @ w_down


def setup_inputs(seed: int = 0) -> dict:
    key = jax.random.key(seed)
    ks = jax.random.split(key, 24)
    nrm = lambda k, shape: jax.random.normal(k, shape, dtype=jnp.float32)
    gain = lambda k, shape: 1.0 + 0.05 * nrm(k, shape)
    D = D_MODEL
    return {
        "x": nrm(ks[0], (BATCH, SEQ, D)),
        "c": nrm(ks[1], (BATCH, D)),
        "ctx": nrm(ks[2], (BATCH, CTX_LEN, D)),
        "c_ctx": nrm(ks[3], (D,)),
        "w_mod": nrm(ks[4], (DEPTH, D, N_MOD * D)) * (0.5 * D ** -0.5),
        "b_mod": 0.01 * nrm(ks[5], (DEPTH, N_MOD * D)),
        "norm1_g": gain(ks[6], (DEPTH, D)),
        "w_in": nrm(ks[7], (DEPTH, D, IN_COLS)) * D ** -0.5,
        "qn_a": gain(ks[8], (DEPTH, HEAD_DIM)),
        "kn_a": gain(ks[9], (DEPTH, HEAD_DIM)),
        "sink_a": 0.5 * nrm(ks[10], (DEPTH, A_HEADS)),
        "qn_b": gain(ks[11], (DEPTH, HEAD_DIM)),
        "kn_b": gain(ks[12], (DEPTH, HEAD_DIM)),
        "rpb_b": 0.1 * nrm(ks[13], (DEPTH, B_HEADS, 2 * NA_MAX_KH - 1, 2 * NA_KW - 1)),
        "on_a": gain(ks[14], (DEPTH, A_WIDTH)),
        "on_b": gain(ks[15], (DEPTH, B_WIDTH)),
        "w_out": nrm(ks[16], (DEPTH, MIX_WIDTH, D)) * MIX_WIDTH ** -0.5,
        "norm2_g": gain(ks[17], (DEPTH, D)),
        "w_gate": nrm(ks[18], (DEPTH, D, FFN_HIDDEN)) * D ** -0.5,
        "w_up": nrm(ks[19], (DEPTH, D, FFN_HIDDEN)) * D ** -0.5,
        "w_down": nrm(ks[20], (DEPTH, FFN_HIDDEN, D)) * FFN_HIDDEN ** -0.5,
    }


def reference(x, c, ctx, c_ctx, w_mod, b_mod, norm1_g, w_in, qn_a, kn_a, sink_a, qn_b, kn_b,
              rpb_b, on_a, on_b, w_out, norm2_g, w_gate, w_up, w_down):
    S = x.shape[1]
    t = jnp.arange(S)
    row_pos = t // GRID_W
    col_pos = t % GRID_W
    for l in range(DEPTH):
        mod = (jax.nn.silu(c) @ w_mod[l] + b_mod[l])[:, None, :]
        mod_c = (jax.nn.silu(c_ctx) @ w_mod[l] + b_mod[l])[None, None, :]
        sh1, sc1, g1, sh2, sc2, g2 = jnp.split(mod, N_MOD, axis=-1)
        csh1, csc1, cg1, csh2, csc2, cg2 = jnp.split(mod_c, N_MOD, axis=-1)

        h = _modulate(_rms_norm(x, norm1_g[l]), sh1, sc1)
        hc = _modulate(_rms_norm(ctx, norm1_g[l]), csh1, csc1)
        q_a, k_a, v_a, q_b, k_b, v_b = _in_proj(h, w_in[l])
        q_ac, k_ac, v_ac, q_bc, k_bc, v_bc = _in_proj(hc, w_in[l])

        q_a = _axial_rope(_rms_norm(q_a, qn_a[l]), row_pos, col_pos)
        k_a = _axial_rope(_rms_norm(k_a, kn_a[l]), row_pos, col_pos)
        q_ac, k_ac = _rms_norm(q_ac, qn_a[l]), _rms_norm(k_ac, kn_a[l])
        q_b, k_b = _rms_norm(q_b, qn_b[l]), _rms_norm(k_b, kn_b[l])
        q_bc, k_bc = _rms_norm(q_bc, qn_b[l]), _rms_norm(k_bc, kn_b[l])

        o_a = _window_gqa_latent(q_a, k_a, v_a, k_ac, v_ac, sink_a[l])
        o_b = _neighbourhood_latent(q_b, k_b, v_b, k_bc, v_bc, rpb_b[l])
        x_new = x + g1 * _merge(o_a, o_b, on_a[l], on_b[l], w_out[l])
        h2 = _modulate(_rms_norm(x_new, norm2_g[l]), sh2, sc2)
        x_new = x_new + g2 * _swiglu(h2, w_gate[l], w_up[l], w_down[l])

        if l < DEPTH - 1:
            o_ac = _ctx_self_attention(q_ac, k_ac, v_ac, A_KV_HEADS, sink_a[l])
            o_bc = _ctx_self_attention(q_bc, k_bc, v_bc, B_HEADS)
            ctx = ctx + cg1 * _merge(o_ac, o_bc, on_a[l], on_b[l], w_out[l])
            hc2 = _modulate(_rms_norm(ctx, norm2_g[l]), csh2, csc2)
            ctx = ctx + cg2 * _swiglu(hc2, w_gate[l], w_up[l], w_down[l])
        x = x_new
    return x
```

```cpp
#include <hip/hip_runtime.h>
#include <hip/hip_cooperative_groups.h>
#include <cstdio>
#include <cstdint>
namespace cg = cooperative_groups;

#ifndef MK_N_LAUNCHES
#define MK_N_LAUNCHES 1
#endif

#define LAS __attribute__((address_space(3)))
typedef unsigned short bf16_t;
typedef short bf16x8 __attribute__((ext_vector_type(8)));
typedef short s16x4 __attribute__((ext_vector_type(4)));
typedef float f32x2 __attribute__((ext_vector_type(2)));
typedef float f32x4 __attribute__((ext_vector_type(4)));
typedef float f32x16 __attribute__((ext_vector_type(16)));
typedef unsigned u32x2 __attribute__((ext_vector_type(2)));
typedef unsigned u32x4 __attribute__((ext_vector_type(4)));
typedef __bf16 bf16x2_t __attribute__((ext_vector_type(2)));

constexpr int DM = 1024, NB = 8, SEQ = 4096, CTXL = 256, ML = NB * SEQ, MC = NB * CTXL, MT = ML + MC;
constexpr int INC = 2304, FFH = 2816, NMOD = 6144;
constexpr float EPS = 1e-6f;
constexpr float LOG2E = 1.4426950408889634f;
constexpr float C2 = 0.125f * LOG2E;
constexpr int NWAVES = 8;

constexpr size_t MiB = 1u << 20, KiB = 1u << 10;
constexpr size_t WS_MOD = 0;
constexpr size_t WS_SSQ1 = 256 * KiB;
constexpr size_t WS_SSQ2 = 512 * KiB;
constexpr size_t WS_BAR = 640 * KiB;
constexpr size_t WS_ZERO_BYTES = 672 * KiB;
constexpr size_t WS_ROPE = 768 * KiB;
constexpr size_t WS_GAINS = 776 * KiB;
constexpr size_t WS_BOUNDS = 780 * KiB;
constexpr size_t WS_BETA = 800 * KiB;
constexpr size_t WS_WIN = 2 * MiB, WS_WOUT = 7 * MiB, WS_WGU = 9 * MiB, WS_WDN = 20 * MiB;
constexpr size_t WS_H = 32 * MiB;
constexpr size_t WS_QKV = 100 * MiB;
constexpr size_t WS_O = 256 * MiB;
constexpr size_t WS_HID = 320 * MiB;
constexpr size_t WS_DUMMY = 496 * MiB;
constexpr size_t WS_END = 497 * MiB;

constexpr int RING_BYTES = 131072, LDX_OFF = RING_BYTES, LDSCTL_OFF = LDX_OFF + 8192, LDS_BYTES = 147456;

__device__ __forceinline__ unsigned cvtpk(float lo, float hi) { f32x2 v = {lo, hi}; bf16x2_t b = __builtin_convertvector(v, bf16x2_t); return __builtin_bit_cast(unsigned, b); }
__device__ __forceinline__ float wave_sum(float v) {
#pragma unroll
    for (int o = 1; o < 64; o <<= 1) v += __shfl_xor(v, o);
    return v;
}
__device__ __forceinline__ float swap_max(float v) { auto rr = __builtin_amdgcn_permlane32_swap(__float_as_uint(v), __float_as_uint(v), false, false); return fmaxf(__uint_as_float(rr[0]), __uint_as_float(rr[1])); }
__device__ __forceinline__ float fq_sum(float v) {
    auto a = __builtin_amdgcn_permlane16_swap(__float_as_uint(v), __float_as_uint(v), false, false); v = __uint_as_float(a[0]) + __uint_as_float(a[1]);
    auto b = __builtin_amdgcn_permlane32_swap(__float_as_uint(v), __float_as_uint(v), false, false); return __uint_as_float(b[0]) + __uint_as_float(b[1]); }
__device__ __forceinline__ u32x4 pair16(u32x2 a, u32x2 b) {
    auto rx = __builtin_amdgcn_permlane16_swap(a.x, b.x, false, false);
    auto ry = __builtin_amdgcn_permlane16_swap(a.y, b.y, false, false);
    u32x4 r; r.x = rx[0]; r.y = ry[0]; r.z = rx[1]; r.w = ry[1]; return r;
}
__device__ __forceinline__ float swap_sum(float v) { auto rr = __builtin_amdgcn_permlane32_swap(__float_as_uint(v), __float_as_uint(v), false, false); return __uint_as_float(rr[0]) + __uint_as_float(rr[1]); }

namespace pg8 {
#define PG8_LAS __attribute__((address_space(3)))
constexpr int BM = 256, BK = 64, HALF = 128, HTB = HALF * BK * 2, STAGE_BYTES = 8 * HTB, NXCD = 8, WGM = 8;
__host__ __device__ __forceinline__ int lds_byte(int r, int c) { const int st = (r >> 4) * 2 + (c >> 5), rr = r & 15, cc = c & 31, ob = rr * 64 + cc * 2; return st * 1024 + (ob ^ (((ob >> 9) & 1) << 5)); }
__host__ __device__ __forceinline__ void stage_rc(int b, int& R, int& C) { const int st = b / 1024, sb = b % 1024, swz = sb ^ (((sb >> 9) & 1) << 5); R = (st >> 1) * 16 + swz / 64; C = (st & 1) * 32 + (swz % 64) / 2; }
__host__ __device__ __forceinline__ int perm32(int rho) { const int n = rho >> 4, i = rho & 15; return 8 * (i >> 2) + 4 * n + (i & 3); }
struct Unit { int pm, pn; };
struct Gemm { const bf16_t* A; const bf16_t* Bt; int M, N, K; };
struct StaticOrder {
    int nM, nN, nwg, G, c;
    __host__ __device__ void init(int M, int N, int G_, int c_) { nM = M / BM; nN = N / BM; nwg = nM * nN; G = G_; c = c_; }
    __host__ __device__ bool next(int i, Unit& u) const {
        const long L = (long)i * G + c; if (L >= nwg) return false;
        int wgid = (int)L; { const int q = nwg / NXCD, r = nwg % NXCD, xcd = wgid % NXCD, off = wgid / NXCD; wgid = (xcd < r ? xcd * (q + 1) : r * (q + 1) + (xcd - r) * q) + off; }
        const int nig = WGM * nN, gid = wgid / nig, fm = gid * WGM, gsz = (nM - fm) < WGM ? (nM - fm) : WGM;
        u.pm = fm + ((wgid % nig) % gsz); u.pn = (wgid % nig) / gsz; return true;
    }
    __device__ __forceinline__ void a_ready(const Unit&) const {}
    __device__ __forceinline__ void done(const Unit&) const {}
};

struct BatchOrder {
    int x, gl, nloc;
    __device__ __forceinline__ bool next(int i, Unit& u) const {
        if (nloc != 32) { const int L = i * nloc + gl; if (L >= 153) return false; const int pn = L / 17, r = L - 17 * pn; u.pn = pn; u.pm = (r < 16) ? 16 * x + r : 128 + x; return true; }
        if (i < 4) { u.pm = 16 * x + (i >> 1) * 8 + (gl & 7); u.pn = (i & 1) * 4 + (gl >> 3); return true; }
        if (i > 4 || gl >= 25) return false;
        if (gl < 16) { u.pm = 16 * x + gl; u.pn = 8; } else { u.pm = 128 + x; u.pn = gl - 16; }
        return true;
    }
};

typedef f32x4 Acc[2][2][4][2];

struct NoPre {};
struct EpiInProj {
    static constexpr bool PERM = false, HAS_MID = false;
    typedef NoPre Pre;
    __device__ __forceinline__ void prefetch(Pre&, const Unit&, int, int, int, int) const {}
    bf16_t* QKV; const float* gains; const float* ropec; const float* ropes;
    __device__ __forceinline__ void mid(Acc&, const Unit&, int, int, int, int) const {}
    __device__ __forceinline__ void operator()(Acc& acc, const Unit& u, int wr, int wc, int fr, int fq, PG8_LAS unsigned char* ldx, const Pre&) const {
        const int pn = u.pn;
        const bool normed0 = pn < 7, normed1 = normed0 && pn != 2;
        PG8_LAS float* X = (PG8_LAS float*)ldx;
        const bool latent = u.pm < (ML / 256);
        const bool isq = (pn < 2) || (pn == 3) || (pn == 4);
        const bool rope = latent && pn <= 2;
        const float* gp = gains + 64 * ((pn < 2) ? 0 : (pn == 2) ? 1 : (pn < 5) ? 2 : 3);
        const int hc = 32 * (wc & 1) + 4 * fq;
        f32x4 g0 = {1.f, 1.f, 1.f, 1.f}, g1 = {1.f, 1.f, 1.f, 1.f};
        if (normed0) { g0 = *(const f32x4*)(gp + hc); g1 = *(const f32x4*)(gp + hc + 16); }
        if (isq) { g0 = g0 * C2; g1 = g1 * C2; }
        f32x4 rc[4], rs[4];
#pragma unroll
        for (int m = 0; m < 4; ++m) { rc[m] = (f32x4){1.f, 1.f, 1.f, 1.f}; rs[m] = (f32x4){0.f, 0.f, 0.f, 0.f}; }
        if (rope) {
#pragma unroll
            for (int m = 0; m < 4; ++m) { const int pos = (wc & 1) ? (16 * m + fr) : ((4 * u.pm + wr) & 63); rc[m] = *(const f32x4*)(ropec + pos * 16 + 4 * fq); rs[m] = *(const f32x4*)(ropes + pos * 16 + 4 * fq); }
        }
        if (normed0) {
#pragma unroll
            for (int ai = 0; ai < 2; ++ai)
#pragma unroll
                for (int m = 0; m < 4; ++m)
#pragma unroll
                    for (int bj = 0; bj < 2; ++bj) {
                        if (bj == 0 || normed1) {
                            const f32x4 a = acc[ai][bj][m][0], b = acc[ai][bj][m][1];
                            float s = (a[0] * a[0] + a[1] * a[1]) + (a[2] * a[2] + a[3] * a[3]) + (b[0] * b[0] + b[1] * b[1]) + (b[2] * b[2] + b[3] * b[3]);
                            s = fq_sum(s);
                            if (fq == 0) X[((ai * 128 + wr * 64 + m * 16 + fr) * 2 + bj) * 4 + wc] = s;
                        }
                    }
            asm volatile("s_waitcnt lgkmcnt(0)" ::: "memory"); __builtin_amdgcn_s_barrier(); asm volatile("" ::: "memory");
        }
#pragma unroll
        for (int ai = 0; ai < 2; ++ai) {
            if (ai == 1 && rope && !(wc & 1)) {
#pragma unroll
                for (int m = 0; m < 4; ++m) { const int pos = (4 * u.pm + 2 + wr) & 63; rc[m] = *(const f32x4*)(ropec + pos * 16 + 4 * fq); rs[m] = *(const f32x4*)(ropes + pos * 16 + 4 * fq); }
            }
#pragma unroll
            for (int m = 0; m < 4; ++m) {
                const int rowl = ai * 128 + wr * 64 + m * 16 + fr;
                const size_t grow = (size_t)u.pm * 256 + rowl;
                const f32x4 cs = rc[m], sn = rs[m];
#pragma unroll
                for (int bj = 0; bj < 2; ++bj) {
                    const bool normed = bj == 0 ? normed0 : normed1;
                    f32x4 v0 = acc[ai][bj][m][0], v1 = acc[ai][bj][m][1];
                    if (normed) {
                        const f32x2 pr = *(const PG8_LAS f32x2*)(X + (rowl * 2 + bj) * 4 + (wc & 2));
                        const float rinv = rsqrtf((pr.x + pr.y) * (1.0f / 64.0f) + EPS);
                        v0 = v0 * rinv * g0; v1 = v1 * rinv * g1;
                        if (rope) { const f32x4 t0 = v0 * cs - v1 * sn, t1 = v0 * sn + v1 * cs; v0 = t0; v1 = t1; }
                    }
                    bf16_t* p = QKV + grow * INC + pn * 256 + bj * 128 + wc * 32 + ((fq & 1) ? 16 + 4 * (fq - 1) : 4 * fq);
                    u32x2 w0, w1; w0.x = cvtpk(v0[0], v0[1]); w0.y = cvtpk(v0[2], v0[3]); w1.x = cvtpk(v1[0], v1[1]); w1.y = cvtpk(v1[2], v1[3]);
                    *(u32x4*)p = pair16(w0, w1);
                }
                asm volatile("" ::: "memory");
            }
        }
    }
};

struct EpiOutProj {
    static constexpr bool PERM = false, HAS_MID = true;
    typedef NoPre Pre;
    __device__ __forceinline__ void prefetch(Pre&, const Unit&, int, int, int, int) const {}
    const float* x; bf16_t* XN; const float* ssq1; float* ssq2; const float* mod; bf16_t* A2; const float* n2g;
    __device__ __forceinline__ void mid(Acc& acc, const Unit& u, int wr, int wc, int fr, int fq) const {
#pragma unroll
        for (int ai = 0; ai < 2; ++ai)
#pragma unroll
            for (int m = 0; m < 4; ++m) {
                const int row = u.pm * 256 + ai * 128 + wr * 64 + m * 16 + fr;
                const f32x2 s = *(const f32x2*)(ssq1 + 2 * (size_t)row);
                const float f = rsqrtf(s.x * (1.0f / 512.0f) + EPS) * sqrtf(s.y * (1.0f / 512.0f) + EPS);
#pragma unroll
                for (int bj = 0; bj < 2; ++bj)
#pragma unroll
                    for (int n = 0; n < 2; ++n) acc[ai][bj][m][n] = acc[ai][bj][m][n] * f;
            }
    }
    __device__ __forceinline__ void operator()(Acc& acc, const Unit& u, int wr, int wc, int fr, int fq, PG8_LAS unsigned char*, const Pre&) const {
        const int b = (u.pm * 256) >> 12;
        const int col0 = u.pn * 256 + wc * 32 + 4 * fq;
        const float* g1p = mod + (size_t)b * NMOD + 2 * DM + col0;
#pragma unroll
        for (int ai = 0; ai < 2; ++ai) {
            f32x4 xv[4][2][2]; float sb[4], ss[4];
#pragma unroll
            for (int m = 0; m < 4; ++m) { const int row = u.pm * 256 + ai * 128 + wr * 64 + m * 16 + fr; sb[m] = ssq1[2 * (size_t)row + 1]; ss[m] = 0.f;
#pragma unroll
                for (int bj = 0; bj < 2; ++bj)
#pragma unroll
                    for (int n = 0; n < 2; ++n) xv[m][bj][n] = *(const f32x4*)(x + (size_t)row * DM + col0 + bj * 128 + n * 16); }
#pragma unroll
            for (int m = 0; m < 4; ++m) sb[m] = rsqrtf(sb[m] * (1.0f / 512.0f) + EPS);
            const int col_st = u.pn * 256 + wc * 32 + ((fq & 1) ? 16 + 4 * (fq - 1) : 4 * fq);
#pragma unroll
            for (int bj = 0; bj < 2; ++bj) {
                const f32x4 gv0 = *(const f32x4*)(g1p + bj * 128), gv1 = *(const f32x4*)(g1p + bj * 128 + 16);
                const f32x4 gm0 = *(const f32x4*)(n2g + col0 + bj * 128) * (*(const f32x4*)(g1p + 2 * DM + bj * 128) + 1.0f);
                const f32x4 gm1 = *(const f32x4*)(n2g + col0 + bj * 128 + 16) * (*(const f32x4*)(g1p + 2 * DM + bj * 128 + 16) + 1.0f);
#pragma unroll
                for (int m = 0; m < 4; ++m) {
                    const int row = u.pm * 256 + ai * 128 + wr * 64 + m * 16 + fr;
                    const f32x4 o0 = xv[m][bj][0] + gv0 * (acc[ai][bj][m][0] * sb[m]), o1 = xv[m][bj][1] + gv1 * (acc[ai][bj][m][1] * sb[m]);
                    ss[m] += ((o0[0] * o0[0] + o0[1] * o0[1]) + (o0[2] * o0[2] + o0[3] * o0[3])) + ((o1[0] * o1[0] + o1[1] * o1[1]) + (o1[2] * o1[2] + o1[3] * o1[3]));
                    const f32x4 a0 = o0 * gm0, a1 = o1 * gm1;
                    u32x2 x0, x1, y0, y1;
                    x0.x = cvtpk(o0[0], o0[1]); x0.y = cvtpk(o0[2], o0[3]); x1.x = cvtpk(o1[0], o1[1]); x1.y = cvtpk(o1[2], o1[3]);
                    y0.x = cvtpk(a0[0], a0[1]); y0.y = cvtpk(a0[2], a0[3]); y1.x = cvtpk(a1[0], a1[1]); y1.y = cvtpk(a1[2], a1[3]);
                    const size_t off = (size_t)row * DM + col_st + bj * 128;
                    *(u32x4*)(XN + (size_t)b * (SEQ * (INC - DM)) + off) = pair16(x0, x1);
                    *(u32x4*)(A2 + off) = pair16(y0, y1);
                }
            }
#pragma unroll
            for (int m = 0; m < 4; ++m) { const int row = u.pm * 256 + ai * 128 + wr * 64 + m * 16 + fr; float t = fq_sum(ss[m]); if (fq == 0) atomicAdd(ssq2 + row, t); }
            asm volatile("" ::: "memory");
        }
    }
};

struct EpiGateUp {
    static constexpr bool PERM = true, HAS_MID = false;
    bf16_t* HID; const float* ssq2; const float* beta;
    struct Pre { f32x4 bg[2], bu[2]; float r2[2][4]; };
    __device__ __forceinline__ void prefetch(Pre& P, const Unit& u, int wr, int wc, int fr, int fq) const {
        const float* bp = beta + (size_t)((u.pm * 256) >> 12) * (2 * FFH) + u.pn * 256 + wc * 32 + 8 * fq;
#pragma unroll
        for (int n = 0; n < 2; ++n) { P.bg[n] = *(const f32x4*)(bp + 4 * n); P.bu[n] = *(const f32x4*)(bp + 128 + 4 * n); }
#pragma unroll
        for (int ai = 0; ai < 2; ++ai)
#pragma unroll
            for (int m = 0; m < 4; ++m) P.r2[ai][m] = ssq2[u.pm * 256 + ai * 128 + wr * 64 + m * 16 + fr];
    }
    __device__ __forceinline__ void mid(Acc&, const Unit&, int, int, int, int) const {}
    __device__ __forceinline__ void operator()(Acc& acc, const Unit& u, int wr, int wc, int fr, int fq, PG8_LAS unsigned char*, const Pre& P) const {
        const int col0 = u.pn * 128 + wc * 32 + 8 * fq;
#pragma unroll
        for (int ai = 0; ai < 2; ++ai)
#pragma unroll
            for (int m = 0; m < 4; ++m) {
                const int row = u.pm * 256 + ai * 128 + wr * 64 + m * 16 + fr;
                const float r2 = rsqrtf(P.r2[ai][m] * (1.0f / DM) + EPS);
                float h[8];
#pragma unroll
                for (int n = 0; n < 2; ++n)
#pragma unroll
                    for (int j = 0; j < 4; ++j) { const float g = acc[ai][0][m][n][j] * r2 + P.bg[n][j], up = acc[ai][1][m][n][j] * r2 + P.bu[n][j];
                        h[n * 4 + j] = g * __builtin_amdgcn_rcpf(1.0f + __builtin_amdgcn_exp2f(-g * LOG2E)) * up; }
                u32x4 w; w.x = cvtpk(h[0], h[1]); w.y = cvtpk(h[2], h[3]); w.z = cvtpk(h[4], h[5]); w.w = cvtpk(h[6], h[7]);
                *(u32x4*)(HID + (size_t)row * FFH + col0) = w;
            }
    }
};

struct EpiDown {
    static constexpr bool PERM = false, HAS_MID = false;
    const bf16_t* src; float* out; const float* mod;
    struct Pre { f32x4 gv[2][2]; };
    __device__ __forceinline__ void prefetch(Pre& P, const Unit& u, int wr, int wc, int fr, int fq) const {
        const float* g2p = mod + (size_t)((u.pm * 256) >> 12) * NMOD + 5 * DM + u.pn * 256 + wc * 32 + 4 * fq;
#pragma unroll
        for (int bj = 0; bj < 2; ++bj)
#pragma unroll
            for (int n = 0; n < 2; ++n) P.gv[bj][n] = *(const f32x4*)(g2p + bj * 128 + n * 16);
    }
    __device__ __forceinline__ void mid(Acc&, const Unit&, int, int, int, int) const {}
    __device__ __forceinline__ void operator()(Acc& acc, const Unit& u, int wr, int wc, int fr, int fq, PG8_LAS unsigned char*, const Pre& P) const {
        const int col0 = u.pn * 256 + wc * 32 + 4 * fq;
#pragma unroll
        for (int ai = 0; ai < 2; ++ai) {
            u32x2 xv[4][2][2];
#pragma unroll
            for (int m = 0; m < 4; ++m) { const int row = u.pm * 256 + ai * 128 + wr * 64 + m * 16 + fr;
#pragma unroll
                for (int bj = 0; bj < 2; ++bj)
#pragma unroll
                    for (int n = 0; n < 2; ++n) xv[m][bj][n] = *(const u32x2*)(src + (size_t)((u.pm * 256) >> 12) * (SEQ * (INC - DM)) + (size_t)row * DM + col0 + bj * 128 + n * 16); }
            const bool lo8 = (fr & 8) == 0;
#pragma unroll
            for (int m = 0; m < 4; ++m) {
                const int rowA = u.pm * 256 + ai * 128 + wr * 64 + m * 16 + (fr & 7);
#pragma unroll
                for (int bj = 0; bj < 2; ++bj) {
                    f32x4 o[2];
#pragma unroll
                    for (int n = 0; n < 2; ++n) { const u32x2 w = xv[m][bj][n]; const f32x4 xf = {__uint_as_float(w.x << 16), __uint_as_float(w.x & 0xffff0000u), __uint_as_float(w.y << 16), __uint_as_float(w.y & 0xffff0000u)};
                        o[n] = xf + P.gv[bj][n] * acc[ai][bj][m][n]; }
                    f32x4 va, vb;
#pragma unroll
                    for (int e = 0; e < 4; ++e) { const float send = lo8 ? o[1][e] : o[0][e];
                        const float recv = __int_as_float(__builtin_amdgcn_mov_dpp(__float_as_int(send), 0x128, 0xf, 0xf, false));
                        va[e] = lo8 ? o[0][e] : recv; vb[e] = lo8 ? recv : o[1][e]; }
                    float* pa = out + (size_t)rowA * DM + col0 + bj * 128 + (lo8 ? 0 : 16);
                    *(f32x4*)pa = va; *(f32x4*)(pa + 8 * DM) = vb;
                }
            }
            asm volatile("" ::: "memory");
        }
    }
};

template <class Epi, class Sched>
__device__ __forceinline__ void gemm_phase(PG8_LAS unsigned char* lds, PG8_LAS unsigned char* ldx, const Gemm g, const Sched& S, const Epi& E, const int wid) {
    int lane; asm volatile("v_mbcnt_lo_u32_b32 %0, -1, 0\n\tv_mbcnt_hi_u32_b32 %0, -1, %0" : "=v"(lane)); const int tid = wid * 64 + lane;
    const int wr = wid >> 2, wc = wid & 3, fr = lane & 15, fq = lane >> 4;
    const int K = g.K, nt = K / BK;
    unsigned voffA[2], voffB[2];
#pragma unroll
    for (int i = 0; i < 2; ++i) { int R, C; stage_rc(tid * 16 + i * 8192, R, C); const int Rb = Epi::PERM ? ((R & ~31) + perm32(R & 31)) : R;
        voffA[i] = (unsigned)(R * K + C) * 2u; voffB[i] = (unsigned)(Rb * K + C) * 2u; }
    const size_t kstep = (size_t)(BK * 2);
    const size_t hstep = (size_t)HALF * K * 2;
    const size_t tstep = 2 * hstep;
    const unsigned ldsw = (unsigned)wid * 1024u;
    const int aoff = lds_byte(wr * 64 + fr, fq * 8), boff = lds_byte(wc * 32 + fr, fq * 8);
#define PG8_SA(b, h) (((b) * 2 + (h)) * HTB)
#define PG8_SB(b, h) ((4 + (b) * 2 + (h)) * HTB)
#define PG8_STAGE(bufoff, gbase, voff) do { _Pragma("unroll") for (int _i = 0; _i < 2; ++_i) \
        __builtin_amdgcn_global_load_lds((const unsigned*)((const char*)(gbase) + (voff)[_i]), (PG8_LAS unsigned*)(lds + (bufoff) + ldsw + _i * 8192), 16, 0, 0); } while (0)
#define PG8_LDA(dst, b, h) do { _Pragma("unroll") for (int m = 0; m < 4; ++m) _Pragma("unroll") for (int k = 0; k < 2; ++k) dst[m][k] = *(const PG8_LAS bf16x8*)(lds + PG8_SA(b, h) + aoff + m * 2048 + k * 1024); } while (0)
#define PG8_LDB(dst, b, h) do { _Pragma("unroll") for (int n = 0; n < 2; ++n) _Pragma("unroll") for (int k = 0; k < 2; ++k) dst[n][k] = *(const PG8_LAS bf16x8*)(lds + PG8_SB(b, h) + boff + n * 2048 + k * 1024); } while (0)
#define PG8_MMA(ai, bj, At, Bt) do { __builtin_amdgcn_s_setprio(1); _Pragma("unroll") for (int m = 0; m < 4; ++m) _Pragma("unroll") for (int n = 0; n < 2; ++n) _Pragma("unroll") for (int k = 0; k < 2; ++k) \
        acc[ai][bj][m][n] = __builtin_amdgcn_mfma_f32_16x16x32_bf16(Bt[n][k], At[m][k], acc[ai][bj][m][n], 0, 0, 0); __builtin_amdgcn_s_setprio(0); } while (0)
#define PG8_WAIT_V(n) asm volatile("s_waitcnt vmcnt(" #n ")" ::: "memory")
#define PG8_WAIT_L(n) asm volatile("s_waitcnt lgkmcnt(" #n ")" ::: "memory")
#define PG8_BAR __builtin_amdgcn_s_barrier()
#define PG8_SCHED __builtin_amdgcn_sched_barrier(0)
    Unit cur, nxt; int ui = 0;
    if (!S.next(0, cur)) return;
    Acc acc;
#pragma unroll
    for (int a = 0; a < 2; ++a)
#pragma unroll
        for (int b = 0; b < 2; ++b)
#pragma unroll
            for (int m = 0; m < 4; ++m)
#pragma unroll
                for (int n = 0; n < 2; ++n) acc[a][b][m][n] = (f32x4){0.f, 0.f, 0.f, 0.f};
    bf16x8 At[4][2], B0[2][2], B1[2][2];
    const char* cA = (const char*)g.A + (size_t)cur.pm * tstep; const char* cB = (const char*)g.Bt + (size_t)cur.pn * tstep;
    typename Epi::Pre pre; E.prefetch(pre, cur, wr, wc, fr, fq);
    PG8_STAGE(PG8_SB(0, 0), cB, voffB); PG8_STAGE(PG8_SB(0, 1), cB + hstep, voffB); PG8_STAGE(PG8_SA(0, 0), cA, voffA); PG8_STAGE(PG8_SA(0, 1), cA + hstep, voffA);
    if (wr == 1) PG8_BAR;
    PG8_WAIT_V(2); PG8_BAR;
    PG8_STAGE(PG8_SB(1, 0), cB + kstep, voffB); PG8_STAGE(PG8_SA(1, 0), cA + kstep, voffA); PG8_STAGE(PG8_SB(1, 1), cB + hstep + kstep, voffB);
    PG8_WAIT_V(6); PG8_BAR;
    for (;;) {
        const bool has_next = S.next(ui + 1, nxt);
        const char* nA = has_next ? (const char*)g.A + (size_t)nxt.pm * tstep : cA; const char* nB = has_next ? (const char*)g.Bt + (size_t)nxt.pn * tstep : cB;
        for (int t = 0; t < nt; t += 2) {
            const bool last = (t == nt - 2);
            const char* a1 = cA + (size_t)(t + 1) * kstep;
            const char* a2 = last ? nA : cA + (size_t)(t + 2) * kstep; const char* b2 = last ? nB : cB + (size_t)(t + 2) * kstep;
            const char* a3 = a2 + kstep; const char* b3 = b2 + kstep;
            if constexpr (Epi::HAS_MID) { if (t == (nt >> 1)) E.mid(acc, cur, wr, wc, fr, fq); }
            PG8_LDB(B0, 0, 0); PG8_LDB(B1, 0, 1); PG8_SCHED; PG8_LDA(At, 0, 0); PG8_STAGE(PG8_SA(1, 1), a1 + hstep, voffA);
            PG8_WAIT_V(8); PG8_WAIT_L(0); PG8_BAR; PG8_MMA(0, 0, At, B0); PG8_MMA(0, 1, At, B1); PG8_BAR; PG8_SCHED;
            PG8_LDA(At, 0, 1); PG8_STAGE(PG8_SB(0, 0), b2, voffB); PG8_STAGE(PG8_SB(0, 1), b2 + hstep, voffB); PG8_STAGE(PG8_SA(0, 0), a2, voffA);
            PG8_WAIT_V(8); PG8_WAIT_L(0); PG8_BAR; PG8_MMA(1, 0, At, B0); PG8_MMA(1, 1, At, B1); PG8_BAR; PG8_SCHED;
            PG8_LDB(B0, 1, 0); PG8_LDB(B1, 1, 1); PG8_SCHED; PG8_LDA(At, 1, 0); PG8_STAGE(PG8_SA(0, 1), a2 + hstep, voffA);
            PG8_WAIT_V(8); PG8_WAIT_L(0); PG8_BAR; PG8_MMA(0, 0, At, B0); PG8_MMA(0, 1, At, B1); PG8_BAR; PG8_SCHED;
            PG8_LDA(At, 1, 1); PG8_STAGE(PG8_SB(1, 0), b3, voffB); PG8_STAGE(PG8_SB(1, 1), b3 + hstep, voffB); PG8_STAGE(PG8_SA(1, 0), a3, voffA);
            PG8_WAIT_V(8); PG8_WAIT_L(0); PG8_BAR; PG8_MMA(1, 0, At, B0); PG8_MMA(1, 1, At, B1); PG8_BAR; PG8_SCHED;
        }
        if (wr == 0) PG8_BAR;
        E(acc, cur, wr, wc, fr, fq, ldx, pre);
        if (!has_next) break;
#pragma unroll
        for (int a = 0; a < 2; ++a)
#pragma unroll
            for (int b = 0; b < 2; ++b)
#pragma unroll
                for (int m = 0; m < 4; ++m)
#pragma unroll
                    for (int n = 0; n < 2; ++n) acc[a][b][m][n] = (f32x4){0.f, 0.f, 0.f, 0.f};
        cur = nxt; cA = nA; cB = nB; ++ui;
        E.prefetch(pre, cur, wr, wc, fr, fq);
        if (wr == 1) PG8_BAR;
    }
    PG8_WAIT_V(0);
    PG8_BAR;
#undef PG8_SA
#undef PG8_SB
#undef PG8_STAGE
#undef PG8_LDA
#undef PG8_LDB
#undef PG8_MMA
#undef PG8_WAIT_V
#undef PG8_WAIT_L
#undef PG8_BAR
#undef PG8_SCHED
}
}

namespace att {
constexpr int KSTR = 144, K_BYTES = 64 * KSTR, V_HALF = 4160, V_BYTES = 2 * V_HALF, BUF_BYTES = K_BYTES + V_BYTES;
constexpr int RPB_OFF = 4 * BUF_BYTES + 1024;
typedef short v4i16_t __attribute__((ext_vector_type(4)));
__device__ __forceinline__ s16x4 vtr(const LAS unsigned char* p) { return __builtin_bit_cast(s16x4, __builtin_amdgcn_ds_read_tr16_b64_v4i16((LAS v4i16_t*)p)); }

template <int MASK, bool FIX>
__device__ __forceinline__ void half_step(const LAS unsigned char* buf, int kvoff, const bf16x8 (&qf)[4], f32x16& o0, f32x16& o1, float& m, float& l,
                                          int lane, int r32, int hi, const LAS float* rpbl, int bidx0, unsigned vmask, const f32x16& cinit) {
    const LAS unsigned char* kp = buf + (kvoff + r32) * KSTR + hi * 16;
    f32x16 s = cinit;
#pragma unroll
    for (int d0 = 0; d0 < 4; ++d0) { const bf16x8 kf = *(const LAS bf16x8*)(kp + d0 * 32); s = __builtin_amdgcn_mfma_f32_32x32x16_bf16(kf, qf[d0], s, 0, 0, 0); }
    const float NEG = -INFINITY;
    if (MASK == 3) {
        float bv[16];
#pragma unroll
        for (int r = 0; r < 16; ++r) bv[r] = rpbl[bidx0 + (r & 3) + 8 * (r >> 2)];
#pragma unroll
        for (int r = 0; r < 16; ++r) asm volatile("" : "+v"(bv[r]));
#pragma unroll
        for (int r = 0; r < 16; ++r) s[r] = ((vmask >> r) & 1u) ? (s[r] + bv[r]) : NEG;
    }
#pragma unroll
    for (int r = 0; r < 16; ++r) {
        const int kl0 = (r & 3) + 8 * (r >> 2);
        if (MASK == 1) { if (kl0 + 4 * hi < r32) s[r] = NEG; }
        if (MASK == 2) { if (kl0 + 4 * hi > r32) s[r] = NEG; }
    }
    if (!FIX) {
        float mx = fmaxf(fmaxf(s[0], s[1]), fmaxf(s[2], s[3]));
#pragma unroll
        for (int r = 4; r < 16; r += 4) mx = fmaxf(mx, fmaxf(fmaxf(s[r], s[r + 1]), fmaxf(s[r + 2], s[r + 3])));
        mx = swap_max(mx);
        const float mnew = fmaxf(m, mx);
        const float msafe = (mnew == NEG) ? 0.f : mnew;
        if (__any(mnew > m)) {
            const float alpha = __builtin_amdgcn_exp2f(m - msafe);
            l *= alpha;
#pragma unroll
            for (int r = 0; r < 16; ++r) { o0[r] *= alpha; o1[r] *= alpha; }
        }
        m = mnew;
        float ls = 0.f;
#pragma unroll
        for (int r = 0; r < 16; ++r) { s[r] = __builtin_amdgcn_exp2f(s[r] - msafe); ls += s[r]; }
        l += ls;
    } else {
#pragma unroll
        for (int r = 0; r < 16; ++r) s[r] = __builtin_amdgcn_exp2f(s[r]);
        l += (((s[0] + s[1]) + (s[2] + s[3])) + ((s[4] + s[5]) + (s[6] + s[7]))) + (((s[8] + s[9]) + (s[10] + s[11])) + ((s[12] + s[13]) + (s[14] + s[15])));
    }
    u32x4 pw0, pw1;
    pw0.x = cvtpk(s[0], s[1]); pw0.y = cvtpk(s[2], s[3]); pw0.z = cvtpk(s[4], s[5]); pw0.w = cvtpk(s[6], s[7]);
    pw1.x = cvtpk(s[8], s[9]); pw1.y = cvtpk(s[10], s[11]); pw1.z = cvtpk(s[12], s[13]); pw1.w = cvtpk(s[14], s[15]);
    const bf16x8 p0 = __builtin_bit_cast(bf16x8, pw0), p1 = __builtin_bit_cast(bf16x8, pw1);
    const LAS unsigned char* vp = buf + K_BYTES + (kvoff + 4 * hi + ((lane & 15) >> 2)) * 64 + 32 * ((lane >> 4) & 1) + 8 * (lane & 3);
#pragma unroll
    for (int dh = 0; dh < 2; ++dh) {
        const s16x4 a0 = vtr(vp + dh * V_HALF), a1 = vtr(vp + dh * V_HALF + 512), b0 = vtr(vp + dh * V_HALF + 1024), b1 = vtr(vp + dh * V_HALF + 1536);
        const bf16x8 vf0 = {a0[0], a0[1], a0[2], a0[3], a1[0], a1[1], a1[2], a1[3]};
        const bf16x8 vf1 = {b0[0], b0[1], b0[2], b0[3], b1[0], b1[1], b1[2], b1[3]};
        if (dh == 0) { o0 = __builtin_amdgcn_mfma_f32_32x32x16_bf16(vf0, p0, o0, 0, 0, 0); o0 = __builtin_amdgcn_mfma_f32_32x32x16_bf16(vf1, p1, o0, 0, 0, 0); }
        else         { o1 = __builtin_amdgcn_mfma_f32_32x32x16_bf16(vf0, p0, o1, 0, 0, 0); o1 = __builtin_amdgcn_mfma_f32_32x32x16_bf16(vf1, p1, o1, 0, 0, 0); }
    }
}

template <bool MASKED>
__device__ __forceinline__ void tile64(const LAS unsigned char* buf, const bf16x8 (&qf)[4], f32x16& o0, f32x16& o1, float& l, int lane, int r32, int hi, const f32x16& cinit,
                                       int a0, int b0, int a1, int b1) {
#define T64_SB() __builtin_amdgcn_sched_barrier(0)
    const LAS unsigned char* kp = buf + r32 * KSTR + hi * 16;
    const LAS unsigned char* vp = buf + K_BYTES + (4 * hi + ((lane & 15) >> 2)) * 64 + 32 * ((lane >> 4) & 1) + 8 * (lane & 3);
    const int dq = 4 * hi - r32; const float NEG = -INFINITY;
    bf16x8 kf0[4], kf1[4];
#pragma unroll
    for (int d0 = 0; d0 < 4; ++d0) { kf0[d0] = *(const LAS bf16x8*)(kp + d0 * 32); kf1[d0] = *(const LAS bf16x8*)(kp + 32 * KSTR + d0 * 32); }
    T64_SB();
    f32x16 s0 = cinit, s1 = cinit;
#pragma unroll
    for (int d0 = 0; d0 < 4; ++d0) s0 = __builtin_amdgcn_mfma_f32_32x32x16_bf16(kf0[d0], qf[d0], s0, 0, 0, 0);
    s16x4 va[2][8];
#pragma unroll
    for (int dh = 0; dh < 2; ++dh)
#pragma unroll
        for (int j = 0; j < 8; ++j) va[dh][j] = vtr(vp + dh * V_HALF + j * 512);
    T64_SB();
#pragma unroll
    for (int d0 = 0; d0 < 4; ++d0) {
        s1 = __builtin_amdgcn_mfma_f32_32x32x16_bf16(kf1[d0], qf[d0], s1, 0, 0, 0);
#pragma unroll
        for (int r = 4 * d0; r < 4 * d0 + 4; ++r) { if (MASKED) { const int t = (r & 3) + 8 * (r >> 2) + dq; if (t < a0 || t > b0) s0[r] = NEG; } s0[r] = __builtin_amdgcn_exp2f(s0[r]); }
        T64_SB();
    }
    u32x4 w00, w01;
    w00.x = cvtpk(s0[0], s0[1]); w00.y = cvtpk(s0[2], s0[3]); w00.z = cvtpk(s0[4], s0[5]); w00.w = cvtpk(s0[6], s0[7]);
    w01.x = cvtpk(s0[8], s0[9]); w01.y = cvtpk(s0[10], s0[11]); w01.z = cvtpk(s0[12], s0[13]); w01.w = cvtpk(s0[14], s0[15]);
    const bf16x8 p00 = __builtin_bit_cast(bf16x8, w00), p01 = __builtin_bit_cast(bf16x8, w01);
    l += (((s0[0] + s0[1]) + (s0[2] + s0[3])) + ((s0[4] + s0[5]) + (s0[6] + s0[7]))) + (((s0[8] + s0[9]) + (s0[10] + s0[11])) + ((s0[12] + s0[13]) + (s0[14] + s0[15])));
#define T64_VF(dh, j) (bf16x8){va[dh][2 * (j)][0], va[dh][2 * (j)][1], va[dh][2 * (j)][2], va[dh][2 * (j)][3], va[dh][2 * (j) + 1][0], va[dh][2 * (j) + 1][1], va[dh][2 * (j) + 1][2], va[dh][2 * (j) + 1][3]}
#define T64_EXP1(R0) do { _Pragma("unroll") for (int r = (R0); r < (R0) + 4; ++r) { if (MASKED) { const int t = (r & 3) + 8 * (r >> 2) + dq; if (t < a1 || t > b1) s1[r] = NEG; } s1[r] = __builtin_amdgcn_exp2f(s1[r]); } } while (0)
    T64_SB();
    o0 = __builtin_amdgcn_mfma_f32_32x32x16_bf16(T64_VF(0, 0), p00, o0, 0, 0, 0); T64_EXP1(0);  T64_SB();
    o1 = __builtin_amdgcn_mfma_f32_32x32x16_bf16(T64_VF(1, 0), p00, o1, 0, 0, 0); T64_EXP1(4);  T64_SB();
    o0 = __builtin_amdgcn_mfma_f32_32x32x16_bf16(T64_VF(0, 1), p01, o0, 0, 0, 0); T64_EXP1(8);  T64_SB();
    o1 = __builtin_amdgcn_mfma_f32_32x32x16_bf16(T64_VF(1, 1), p01, o1, 0, 0, 0); T64_EXP1(12); T64_SB();
    u32x4 w10, w11;
    w10.x = cvtpk(s1[0], s1[1]); w10.y = cvtpk(s1[2], s1[3]); w10.z = cvtpk(s1[4], s1[5]); w10.w = cvtpk(s1[6], s1[7]);
    w11.x = cvtpk(s1[8], s1[9]); w11.y = cvtpk(s1[10], s1[11]); w11.z = cvtpk(s1[12], s1[13]); w11.w = cvtpk(s1[14], s1[15]);
    const bf16x8 p10 = __builtin_bit_cast(bf16x8, w10), p11 = __builtin_bit_cast(bf16x8, w11);
    l += (((s1[0] + s1[1]) + (s1[2] + s1[3])) + ((s1[4] + s1[5]) + (s1[6] + s1[7]))) + (((s1[8] + s1[9]) + (s1[10] + s1[11])) + ((s1[12] + s1[13]) + (s1[14] + s1[15])));
    o0 = __builtin_amdgcn_mfma_f32_32x32x16_bf16(T64_VF(0, 2), p10, o0, 0, 0, 0);
    o1 = __builtin_amdgcn_mfma_f32_32x32x16_bf16(T64_VF(1, 2), p10, o1, 0, 0, 0);
    o0 = __builtin_amdgcn_mfma_f32_32x32x16_bf16(T64_VF(0, 3), p11, o0, 0, 0, 0);
    o1 = __builtin_amdgcn_mfma_f32_32x32x16_bf16(T64_VF(1, 3), p11, o1, 0, 0, 0);
#undef T64_VF
#undef T64_EXP1
#undef T64_SB
}

__device__ __forceinline__ int clampi(int v, int lo, int hi) { return v < lo ? lo : (v > hi ? hi : v); }

template <int MODE, bool FIX>
__device__ __forceinline__ void attn_unit(LAS unsigned char* lds, const bf16_t* __restrict__ QKV, bf16_t* __restrict__ O, float* ssq1, const float* __restrict__ sinkp,
                                          const float* __restrict__ rpb, int unit, int tid, int lane, int wid, const float Mb) {
    const int r32 = lane & 31, hi = lane >> 5;
    const int b = unit >> 7, rem = unit & 127;
    int head, qtok, qcol, kcol, vcol, ocol, NTL, lrow0;
    int s_sub = 0, tl0 = 0;
    int qrow = 0, qc = 0, kc0 = 0, kr_lo = 0, wa_lo = 0, wa_hi = 0, rs = 0;
    unsigned colmask = 0u;
    if (MODE == 0) {
        const int qblk = rem >> 1, kvh = rem & 1, q0 = qblk * 64;
        head = kvh * 4 + (wid >> 1); s_sub = wid & 1; qtok = q0 + 32 * s_sub + r32; qcol = head * 64; kcol = 512 + kvh * 64; vcol = 640 + kvh * 64; ocol = head * 64;
        tl0 = (2 - qblk) > 0 ? (2 - qblk) : 0; const int tl1 = (65 - qblk) < 4 ? (65 - qblk) : 4; NTL = tl1 - tl0 + 1; lrow0 = b * SEQ + q0 - 128 + 64 * tl0;
    } else {
        head = rem >> 4; const int r0 = 4 * (rem & 15), rp = wid >> 2, cgp = wid & 3;
        qrow = r0 + 2 * rp + (r32 >> 4); qc = 16 * cgp + (r32 & 15); qtok = qrow * 64 + qc; qcol = 768 + head * 64; kcol = 1280 + head * 64; vcol = 1792 + head * 64; ocol = 512 + head * 64;
        kr_lo = (r0 - 4) > 0 ? (r0 - 4) : 0; const int kr_hi = clampi(r0 - 1, 0, 56) + 7; NTL = kr_hi - kr_lo + 1; lrow0 = b * SEQ + kr_lo * 64;
        kc0 = clampi(16 * cgp - 8, 0, 32); const int cs = clampi(qc - 8, 0, 48);
        wa_lo = clampi(r0 + 2 * rp - 4, 0, 56); wa_hi = clampi(r0 + 2 * rp - 3, 0, 56) + 7; rs = clampi(qrow - 4, 0, 56);
#pragma unroll
        for (int r = 0; r < 16; ++r) { const int kc = kc0 + (r & 3) + 8 * (r >> 2) + 4 * hi; if ((unsigned)(kc - cs) < 16u) colmask |= (1u << r); }
        LAS float* rt = (LAS float*)(lds + RPB_OFF);
        if (tid < 465) rt[tid] = rpb[head * 465 + tid] * LOG2E;
    }
    const int NT = NTL + 4, crow0 = ML + b * CTXL;
    const LAS float* rpbl = (const LAS float*)(lds + RPB_OFF);
    bf16x8 qf[4];
    { const bf16_t* qp = QKV + (size_t)(b * SEQ + qtok) * INC + qcol + hi * 8;
#pragma unroll
      for (int d0 = 0; d0 < 4; ++d0) qf[d0] = *(const bf16x8*)(qp + d0 * 16); }
    float m = FIX ? Mb : -INFINITY, l = 0.f;
    const float ci = FIX ? -Mb : 0.f;
    const f32x16 cinit = {ci, ci, ci, ci, ci, ci, ci, ci, ci, ci, ci, ci, ci, ci, ci, ci};
    f32x16 o0 = {0.f, 0.f, 0.f, 0.f, 0.f, 0.f, 0.f, 0.f, 0.f, 0.f, 0.f, 0.f, 0.f, 0.f, 0.f, 0.f}, o1 = o0;
    const int srow = tid >> 3, sch = tid & 7;
    const bf16_t* gk = QKV + (size_t)srow * INC + kcol + sch * 8;
    const bf16_t* gv = QKV + (size_t)srow * INC + vcol + sch * 8;
    const unsigned kwoff = srow * KSTR + sch * 16, vwoff = K_BYTES + (sch >> 2) * V_HALF + srow * 64 + (sch & 3) * 16;
#define ATT_TROW(i) ((i) < NTL ? lrow0 + 64 * (i) : crow0 + 64 * ((i) - NTL))
#define ATT_LOAD(KR, VR, i) do { const size_t ro_ = (size_t)ATT_TROW(i) * INC; KR = *(const u32x4*)(gk + ro_); VR = *(const u32x4*)(gv + ro_); } while (0)
#define ATT_COMPUTE(i, buf) do { \
        if ((i) < NTL) { \
            if (MODE == 0) { \
                const int tl = tl0 + (i); \
                if (FIX) { \
                    const int dA = 2 * tl - s_sub, dB = dA + 1; \
                    if (dA >= 1 && dB <= 7) tile64<false>(buf, qf, o0, o1, l, lane, r32, hi, cinit, 0, 0, 0, 0); \
                    else { const int a0 = (dA < 0 || dA > 8) ? 99 : (dA == 0 ? 0 : -99), b0 = (dA < 0 || dA > 8) ? -99 : (dA == 8 ? 0 : 99); \
                           const int a1 = (dB < 0 || dB > 8) ? 99 : (dB == 0 ? 0 : -99), b1 = (dB < 0 || dB > 8) ? -99 : (dB == 8 ? 0 : 99); \
                           tile64<true>(buf, qf, o0, o1, l, lane, r32, hi, cinit, a0, b0, a1, b1); } \
                } else { \
                _Pragma("unroll") for (int hlf = 0; hlf < 2; ++hlf) { \
                    const int d = 2 * tl + hlf - s_sub; \
                    if (d == 0) half_step<1, FIX>(buf, 32 * hlf, qf, o0, o1, m, l, lane, r32, hi, rpbl, 0, 0u, cinit); \
                    else if (d == 8) half_step<2, FIX>(buf, 32 * hlf, qf, o0, o1, m, l, lane, r32, hi, rpbl, 0, 0u, cinit); \
                    else if (d > 0 && d < 8) half_step<0, FIX>(buf, 32 * hlf, qf, o0, o1, m, l, lane, r32, hi, rpbl, 0, 0u, cinit); \
                } } \
            } else { \
                const int kr = kr_lo + (i); \
                if (kr >= wa_lo && kr <= wa_hi) { \
                    const unsigned vm = ((unsigned)(kr - rs) < 8u) ? colmask : 0u; \
                    const int bidx0 = (kr - qrow + 7) * 31 + kc0 + 4 * hi - qc + 15; \
                    half_step<3, FIX>(buf, kc0, qf, o0, o1, m, l, lane, r32, hi, rpbl, bidx0, vm, cinit); \
                } \
            } \
        } else if (FIX) { \
            tile64<false>(buf, qf, o0, o1, l, lane, r32, hi, cinit, 0, 0, 0, 0); \
        } else { \
            half_step<0, FIX>(buf, 0, qf, o0, o1, m, l, lane, r32, hi, rpbl, 0, 0u, cinit); \
            half_step<0, FIX>(buf, 32, qf, o0, o1, m, l, lane, r32, hi, rpbl, 0, 0u, cinit); \
        } } while (0)
    if (FIX) {
        int nmask, nl1, tlu0;
        if (MODE == 0) { const int tl1 = tl0 + NTL - 1; nmask = (tl0 == 0 ? 1 : 0) + (tl1 == 4 ? 1 : 0); tlu0 = tl0 > 1 ? tl0 : 1; nl1 = (tl1 < 3 ? tl1 : 3) - tlu0 + 1; }
        else { nmask = NTL; nl1 = 0; tlu0 = 0; }
        const int lbase = (MODE == 0) ? (b * SEQ + 64 * (rem >> 1) - 128) : lrow0;
#define ATT_SEQ_TL(i) ((MODE == 0) ? (((i) == 0 && tl0 == 0) ? 0 : 4) : (i))
#define ATT_SEQ_ROW(i) ((i) < nmask ? lbase + 64 * ATT_SEQ_TL(i) : ((i) - nmask < nl1 ? lbase + 64 * (tlu0 + (i) - nmask) : crow0 + 64 * ((i) - nmask - nl1)))
#define ATT_STEP_PRE(i) \
            LAS unsigned char* buf = lds + ((i) & 1) * BUF_BYTES; \
            *(LAS u32x4*)(buf + kwoff) = kA; *(LAS u32x4*)(buf + vwoff) = vA; \
            asm volatile("s_waitcnt lgkmcnt(0)\n\ts_barrier" ::: "memory"); \
            { const int in_ = ((i) + 1 < NT) ? (i) + 1 : (i); const size_t ro_ = (size_t)ATT_SEQ_ROW(in_) * INC; kA = *(const u32x4*)(gk + ro_); vA = *(const u32x4*)(gv + ro_); }
        u32x4 kA, vA;
        { const size_t ro_ = (size_t)ATT_SEQ_ROW(0) * INC; kA = *(const u32x4*)(gk + ro_); vA = *(const u32x4*)(gv + ro_); }
        int i = 0;
        for (; i < nmask; ++i) {
            ATT_STEP_PRE(i)
            if (MODE == 0) {
                const int tl = ATT_SEQ_TL(i); const int dA = 2 * tl - s_sub, dB = dA + 1;
                const int a0 = (dA < 0 || dA > 8) ? 99 : (dA == 0 ? 0 : -99), b0 = (dA < 0 || dA > 8) ? -99 : (dA == 8 ? 0 : 99);
                const int a1 = (dB < 0 || dB > 8) ? 99 : (dB == 0 ? 0 : -99), b1 = (dB < 0 || dB > 8) ? -99 : (dB == 8 ? 0 : 99);
                if (dA < 0) half_step<1, true>(buf, 32, qf, o0, o1, m, l, lane, r32, hi, rpbl, 0, 0u, cinit);
                else if (dB > 8) half_step<2, true>(buf, 0, qf, o0, o1, m, l, lane, r32, hi, rpbl, 0, 0u, cinit);
                else tile64<true>(buf, qf, o0, o1, l, lane, r32, hi, cinit, a0, b0, a1, b1);
            } else {
                const int kr = kr_lo + i;
                if (kr >= wa_lo && kr <= wa_hi) {
                    const unsigned vm = ((unsigned)(kr - rs) < 8u) ? colmask : 0u;
                    const int bidx0 = (kr - qrow + 7) * 31 + kc0 + 4 * hi - qc + 15;
                    half_step<3, true>(buf, kc0, qf, o0, o1, m, l, lane, r32, hi, rpbl, bidx0, vm, cinit);
                }
            }
        }
        for (; i < NT; ++i) {
            ATT_STEP_PRE(i)
            tile64<false>(buf, qf, o0, o1, l, lane, r32, hi, cinit, 0, 0, 0, 0);
        }
#undef ATT_SEQ_TL
#undef ATT_SEQ_ROW
#undef ATT_STEP_PRE
    } else {
    u32x4 kA, vA, kB, vB;
    const int NP = (NT + 1) >> 1;
    ATT_LOAD(kA, vA, 0); ATT_LOAD(kB, vB, 1);
    for (int j = 0; j < NP; ++j) {
        LAS unsigned char* buf = lds + (j & 1) * (2 * BUF_BYTES);
        const int i0 = 2 * j; const bool two = (i0 + 1 < NT);
        *(LAS u32x4*)(buf + kwoff) = kA; *(LAS u32x4*)(buf + vwoff) = vA;
        if (two) { *(LAS u32x4*)(buf + BUF_BYTES + kwoff) = kB; *(LAS u32x4*)(buf + BUF_BYTES + vwoff) = vB; }
        asm volatile("s_waitcnt lgkmcnt(0)\n\ts_barrier" ::: "memory");
        if (i0 + 2 < NT) ATT_LOAD(kA, vA, i0 + 2);
        if (i0 + 3 < NT) ATT_LOAD(kB, vB, i0 + 3);
        ATT_COMPUTE(i0, buf);
        if (two) { const LAS unsigned char* buf2 = buf + BUF_BYTES; ATT_COMPUTE(i0 + 1, buf2); }
    }
    }
#undef ATT_LOAD
#undef ATT_COMPUTE
#undef ATT_TROW
    float lt = swap_sum(l);
    if (MODE == 0) lt += __builtin_amdgcn_exp2f(sinkp[head] * LOG2E - m);
    const float inv = 1.0f / lt;
    float ss = 0.f;
#pragma unroll
    for (int r = 0; r < 16; ++r) { o0[r] *= inv; o1[r] *= inv; ss += o0[r] * o0[r] + o1[r] * o1[r]; }
    ss = swap_sum(ss);
    const size_t orow = (size_t)(b * SEQ + qtok);
    if (hi == 0) atomicAdd(ssq1 + 2 * orow + MODE, ss);
    bf16_t* op = O + orow * DM + ocol + (hi ? 8 : 0);
#pragma unroll
    for (int j = 0; j < 2; ++j) {
        u32x2 a0, b0, a1, b1;
        a0.x = cvtpk(o0[8 * j], o0[8 * j + 1]); a0.y = cvtpk(o0[8 * j + 2], o0[8 * j + 3]); b0.x = cvtpk(o0[8 * j + 4], o0[8 * j + 5]); b0.y = cvtpk(o0[8 * j + 6], o0[8 * j + 7]);
        a1.x = cvtpk(o1[8 * j], o1[8 * j + 1]); a1.y = cvtpk(o1[8 * j + 2], o1[8 * j + 3]); b1.x = cvtpk(o1[8 * j + 4], o1[8 * j + 5]); b1.y = cvtpk(o1[8 * j + 6], o1[8 * j + 7]);
        auto x0 = __builtin_amdgcn_permlane32_swap(a0.x, b0.x, false, false); auto y0 = __builtin_amdgcn_permlane32_swap(a0.y, b0.y, false, false);
        auto x1 = __builtin_amdgcn_permlane32_swap(a1.x, b1.x, false, false); auto y1 = __builtin_amdgcn_permlane32_swap(a1.y, b1.y, false, false);
        u32x4 w0, w1; w0.x = x0[0]; w0.y = y0[0]; w0.z = x0[1]; w0.w = y0[1]; w1.x = x1[0]; w1.y = y1[0]; w1.z = x1[1]; w1.w = y1[1];
        *(u32x4*)(op + 16 * j) = w0; *(u32x4*)(op + 32 + 16 * j) = w1;
    }
    asm volatile("s_waitcnt lgkmcnt(0)\n\ts_barrier" ::: "memory");
}
}

template <int MODE>
__device__ __forceinline__ void transpose_item(const float* __restrict__ W, int K, int N, bf16_t* __restrict__ WT, LAS float* scr, int item, int lane, const float* __restrict__ ga, const float* __restrict__ gb) {
    const int nblk = N / 32, kb = item / nblk, nb = item % nblk, k0 = 64 * kb, n0 = 32 * nb;
#pragma unroll 8
    for (int i = 0; i < 32; ++i) { const int kk = 2 * i + (lane >> 5); float v = W[(size_t)(k0 + kk) * N + n0 + (lane & 31)];
        if (MODE == 1) { const int k = k0 + kk; v *= (k < 512) ? ga[k] : gb[k - 512]; }
        scr[kk * 33 + (lane & 31)] = v; }
    asm volatile("s_waitcnt lgkmcnt(0)" ::: "memory");
    const int c = lane & 7;
#pragma unroll
    for (int j = 0; j < 4; ++j) { const int n = (lane >> 3) + 8 * j; const LAS float* s = scr + (8 * c) * 33 + n;
        u32x4 o; o.x = cvtpk(s[0 * 33], s[1 * 33]); o.y = cvtpk(s[2 * 33], s[3 * 33]); o.z = cvtpk(s[4 * 33], s[5 * 33]); o.w = cvtpk(s[6 * 33], s[7 * 33]);
        const int nn = n0 + n; int drow = nn;
        if (MODE == 2) drow = 256 * (nn >> 7) + (nn & 127);
        if (MODE == 3) drow = 256 * (nn >> 7) + 128 + (nn & 127);
        *(u32x4*)(WT + (size_t)drow * K + k0 + 8 * c) = o; }
    asm volatile("s_waitcnt lgkmcnt(0)" ::: "memory");
}

struct Args { const float* in[21]; float* out; unsigned char* ws; int ph_lo, ph_hi; };

enum { I_X = 0, I_C, I_CTX, I_CCTX, I_WMOD, I_BMOD, I_N1G, I_WIN, I_QNA, I_KNA, I_SINK, I_QNB, I_KNB, I_RPB, I_ONA, I_ONB, I_WOUT, I_N2G, I_WGATE, I_WUP, I_WDOWN };

#define XB_TMO      128
#define XB_XCNT(j)  (256  + 64 * (j))
#define XB_XSUB(j)  (1280 + 64 * (j))
#define XB_XGEN(j)  (2304 + 64 * (j))
#define XB_TOP      3328
#define XB_TOPGEN   3392
#define XCD_BAR_WORDS 3456
#define XB_SPIN_CAP (1u << 18)
__device__ __forceinline__ unsigned xb_ld(unsigned* p)              { return __hip_atomic_load(p, __ATOMIC_RELAXED, __HIP_MEMORY_SCOPE_AGENT); }
__device__ __forceinline__ unsigned xb_add(unsigned* p, unsigned v) { return __hip_atomic_fetch_add(p, v, __ATOMIC_RELAXED, __HIP_MEMORY_SCOPE_AGENT); }
__device__ __forceinline__ unsigned xb_xcc_id() { return (unsigned)__builtin_amdgcn_s_getreg((3 << 11) | 20) & 0xFu; }
#define XB_SPIN(cond, bar) do { unsigned _sp = 0; while (cond) { __builtin_amdgcn_s_sleep(1); \
    if ((++_sp & 255u) == 0u) { if (xb_ld(&(bar)[XB_TMO])) break; if (_sp > XB_SPIN_CAP) { atomicAdd(&(bar)[XB_TMO], 1u); break; } } } } while (0)
__device__ __forceinline__ void xcd_barrier_complete(unsigned* bar, unsigned x, unsigned G, unsigned& nloc, unsigned& nx) {
    unsigned sum, cnt, mine, sp = 0u;
    for (;;) {
        sum = 0u; cnt = 0u; mine = 0u;
#pragma unroll
        for (unsigned j = 0; j < 16; ++j) { const unsigned c = xb_ld(&bar[XB_XCNT(j)]); sum += c; cnt += (c > 0u) ? 1u : 0u; mine = (j == x) ? c : mine; }
        if (sum == G) break;
        __builtin_amdgcn_s_sleep(1);
        if ((++sp & 255u) == 0u) { if (xb_ld(&bar[XB_TMO])) break; if (sp > XB_SPIN_CAP) { atomicAdd(&bar[XB_TMO], 1u); break; } }
    }
    nloc = mine > 0u ? mine : 1u; nx = cnt > 0u ? cnt : 1u;
}
__device__ __forceinline__ void xcd_barrier(unsigned* bar, unsigned x, volatile LAS unsigned* st, unsigned G, int tid) {
    asm volatile("s_waitcnt vmcnt(0)" ::: "memory");
    __syncthreads();
    if (tid == 0) {
        __builtin_amdgcn_s_waitcnt(0);
        unsigned nloc = st[0], nx = st[1];
        if (nloc == 0u) { xcd_barrier_complete(bar, x, G, nloc, nx); st[0] = nloc; st[1] = nx; }
        const unsigned old = xb_add(&bar[XB_XSUB(x)], 1u);
        const unsigned gen = old / nloc;
        if (old + 1u == (gen + 1u) * nloc) {
            __builtin_amdgcn_fence(__ATOMIC_RELEASE, "agent");
            asm volatile("s_waitcnt vmcnt(0)" ::: "memory");
            const unsigned og = xb_add(&bar[XB_TOP], 1u);
            const unsigned tg = og / nx;
            if (og + 1u == (tg + 1u) * nx) xb_add(&bar[XB_TOPGEN], 1u);
            else XB_SPIN(xb_ld(&bar[XB_TOPGEN]) == tg, bar);
            __builtin_amdgcn_fence(__ATOMIC_ACQUIRE, "agent");
            xb_add(&bar[XB_XGEN(x)], 1u);
            asm volatile("s_waitcnt vmcnt(0)" ::: "memory");
        } else {
            XB_SPIN(xb_ld(&bar[XB_XGEN(x)]) == gen, bar);
            __builtin_amdgcn_fence(__ATOMIC_ACQUIRE, "agent");
            asm volatile("s_waitcnt vmcnt(0)" ::: "memory");
        }
    }
    __syncthreads();
}
__device__ __forceinline__ void grp_barrier(unsigned* bar2, unsigned x, unsigned nloc, int tid) {
    asm volatile("s_waitcnt vmcnt(0)" ::: "memory");
    __syncthreads();
    if (tid == 0) {
        __builtin_amdgcn_s_waitcnt(0);
        const unsigned old = xb_add(&bar2[XB_XSUB(x)], 1u);
        const unsigned gen = old / nloc;
        if (old + 1u == (gen + 1u) * nloc) {
            __builtin_amdgcn_fence(__ATOMIC_ACQUIRE, "agent");
            xb_add(&bar2[XB_XGEN(x)], 1u);
            asm volatile("s_waitcnt vmcnt(0)" ::: "memory");
        } else {
            XB_SPIN(xb_ld(&bar2[XB_XGEN(x)]) == gen, bar2);
            __builtin_amdgcn_fence(__ATOMIC_ACQUIRE, "agent");
            asm volatile("s_waitcnt vmcnt(0)" ::: "memory");
        }
    }
    __syncthreads();
}
typedef const char __attribute__((address_space(4)))* kaptr_t;
__device__ __forceinline__ const float* ka_ptr(kaptr_t ka, int off) { unsigned long long p; asm volatile("s_load_dwordx2 %0, %1, %2\n\ts_waitcnt lgkmcnt(0)" : "=s"(p) : "s"(ka), "i"(off) : "memory");
    return (const float*)(const __attribute__((address_space(1))) float*)p; }
__device__ __forceinline__ int ka_int(kaptr_t ka, int off) { int v; asm volatile("s_load_dword %0, %1, %2\n\ts_waitcnt lgkmcnt(0)" : "=s"(v) : "s"(ka), "i"(off) : "memory"); return v; }

__global__ void __launch_bounds__(NWAVES * 64, 2) fwd_kernel(Args args_unused) {
    extern __shared__ __attribute__((aligned(16))) unsigned char lds_raw[];
    LAS unsigned char* lds = (LAS unsigned char*)lds_raw;
    const kaptr_t ka = (kaptr_t)__builtin_amdgcn_kernarg_segment_ptr();
#define ARGP(i) ka_ptr(ka, (i) * 8)
#define ARG_OUT() ((float*)ka_ptr(ka, 168))
#define ARG_WS() ((unsigned char*)ka_ptr(ka, 176))
    const int wave = __builtin_amdgcn_readfirstlane(threadIdx.x >> 6);
#define GET_LANE() int lane; asm volatile("v_mbcnt_lo_u32_b32 %0, -1, 0\n\tv_mbcnt_hi_u32_b32 %0, -1, %0" : "=v"(lane)); const int tid = wave * 64 + lane; (void)tid;
    const int G = gridDim.x; const int bx = blockIdx.x; const int vcu = (G % 8 == 0) ? (bx % 8) * (G / 8) + bx / 8 : bx;
    const int lo = ka_int(ka, 184), hi = ka_int(ka, 188);
    const int gw = vcu * NWAVES + wave, NGW = G * NWAVES;
    if (lo > 1000) cg::this_grid().sync();
    const unsigned xcc = xb_xcc_id();
    { GET_LANE(); if (tid < 4) ((volatile LAS unsigned*)(lds + LDSCTL_OFF))[tid] = 0u; __syncthreads();
      if (hi - lo > 1 && tid == 0) ((volatile LAS unsigned*)(lds + LDSCTL_OFF))[2] = xb_add((unsigned*)(ARG_WS() + WS_BAR) + XB_XCNT(xcc), 1u);
      __syncthreads(); }
#ifndef PH_MASK
#define PH_MASK 255
#endif
#define IN(k) (((PH_MASK >> (k)) & 1) && lo <= (k) && (k) < hi)
#ifndef DUP_MASK
#define DUP_MASK 0
#endif
#define NREP(k) ((((DUP_MASK) >> (k)) & 1) ? 2 : 1)
#define FIRST_OF_2(k) ((((DUP_MASK) >> (k)) & 1) && rep == 0)
#define SEAM(k) do { if (IN(k) && IN((k) + 1)) { GET_LANE(); xcd_barrier((unsigned*)(ARG_WS() + WS_BAR), xcc, (volatile LAS unsigned*)(lds + LDSCTL_OFF), (unsigned)G, tid); } } while (0)

    if (IN(0)) for (int rep = 0; rep < NREP(0); ++rep) {
        GET_LANE();
        unsigned char* const ws = ARG_WS();
        float* const mod = (float*)(ws + (FIRST_OF_2(0) ? WS_DUMMY : WS_MOD));
        LAS float* scr = (LAS float*)(lds + wave * 16384);
        constexpr int I_GEMV = 96 * 32, I_IN = 16 * 72, I_OUT = 16 * 32, I_G = 16 * 88, I_D = 44 * 32, I_ROPE = 16 + 4 + 1;
        constexpr int NITEMS = I_GEMV + I_IN + I_OUT + 2 * I_G + I_D + I_ROPE;
        for (int it = gw; it < NITEMS; it += NGW) {
            int r = it;
            if (r < I_GEMV) {
                const int cb = r % 96, kc = r / 96, col = cb * 64 + lane, k0 = kc * 32;
                const float* cin = ARGP(I_C); const float* cc = ARGP(I_CCTX);
                for (int idx = lane; idx < 9 * 32; idx += 64) { const int bb = idx >> 5, kk = idx & 31; const float v = (bb < 8) ? cin[bb * DM + k0 + kk] : cc[k0 + kk]; scr[idx] = v / (1.0f + __expf(-v)); }
                asm volatile("s_waitcnt lgkmcnt(0)" ::: "memory");
                float a0 = 0.f, a1 = 0.f, a2 = 0.f, a3 = 0.f, a4 = 0.f, a5 = 0.f, a6 = 0.f, a7 = 0.f, a8 = 0.f;
                const float* wp = ARGP(I_WMOD) + (size_t)k0 * NMOD + col;
#pragma unroll 16
                for (int kk = 0; kk < 32; ++kk) { const float w = wp[(size_t)kk * NMOD];
                    a0 += scr[kk] * w; a1 += scr[32 + kk] * w; a2 += scr[64 + kk] * w; a3 += scr[96 + kk] * w; a4 += scr[128 + kk] * w; a5 += scr[160 + kk] * w; a6 += scr[192 + kk] * w; a7 += scr[224 + kk] * w; a8 += scr[256 + kk] * w; }
                const float bm = (kc == 0) ? ARGP(I_BMOD)[col] : 0.f;
                atomicAdd(mod + 0 * NMOD + col, a0 + bm); atomicAdd(mod + 1 * NMOD + col, a1 + bm); atomicAdd(mod + 2 * NMOD + col, a2 + bm); atomicAdd(mod + 3 * NMOD + col, a3 + bm);
                atomicAdd(mod + 4 * NMOD + col, a4 + bm); atomicAdd(mod + 5 * NMOD + col, a5 + bm); atomicAdd(mod + 6 * NMOD + col, a6 + bm); atomicAdd(mod + 7 * NMOD + col, a7 + bm);
                atomicAdd(mod + 8 * NMOD + col, a8 + bm);
                asm volatile("s_waitcnt lgkmcnt(0)" ::: "memory");
                continue;
            }
            r -= I_GEMV;
            if (r < I_IN) { transpose_item<0>(ARGP(I_WIN), DM, INC, (bf16_t*)(ws + WS_WIN), scr, r, lane, nullptr, nullptr); continue; } r -= I_IN;
            if (r < I_OUT) { transpose_item<1>(ARGP(I_WOUT), DM, DM, (bf16_t*)(ws + WS_WOUT), scr, r, lane, ARGP(I_ONA), ARGP(I_ONB)); continue; } r -= I_OUT;
            if (r < I_G) { transpose_item<2>(ARGP(I_WGATE), DM, FFH, (bf16_t*)(ws + WS_WGU), scr, r, lane, nullptr, nullptr); continue; } r -= I_G;
            if (r < I_G) { transpose_item<3>(ARGP(I_WUP), DM, FFH, (bf16_t*)(ws + WS_WGU), scr, r, lane, nullptr, nullptr); continue; } r -= I_G;
            if (r < I_D) { transpose_item<0>(ARGP(I_WDOWN), FFH, DM, (bf16_t*)(ws + WS_WDN), scr, r, lane, nullptr, nullptr); continue; } r -= I_D;
            if (r == 20) {
                float ga = fabsf(ARGP(I_QNA)[lane]), gb = fabsf(ARGP(I_KNA)[lane]), gc = fabsf(ARGP(I_QNB)[lane]), gd = fabsf(ARGP(I_KNB)[lane]), rm = 0.f;
                const float* rp = ARGP(I_RPB);
                for (int idx = lane; idx < 8 * 465; idx += 64) rm = fmaxf(rm, fabsf(rp[idx]));
#pragma unroll
                for (int o = 1; o < 64; o <<= 1) { ga = fmaxf(ga, __shfl_xor(ga, o)); gb = fmaxf(gb, __shfl_xor(gb, o)); gc = fmaxf(gc, __shfl_xor(gc, o)); gd = fmaxf(gd, __shfl_xor(gd, o)); rm = fmaxf(rm, __shfl_xor(rm, o)); }
                if (lane == 0) { float* bd = (float*)(ws + WS_BOUNDS); bd[0] = 64.0f * C2 * ga * gb * 1.02f; bd[1] = 64.0f * C2 * gc * gd * 1.02f + rm * LOG2E; }
                continue; }
            if (r >= 16) { const int t = r - 16; float gvv; if (t == 0) gvv = ARGP(I_QNA)[lane]; else if (t == 1) gvv = ARGP(I_KNA)[lane]; else if (t == 2) gvv = ARGP(I_QNB)[lane]; else gvv = ARGP(I_KNB)[lane];
                ((float*)(ws + WS_GAINS))[t * 64 + lane] = gvv; continue; }
            { const int idx = r * 64 + lane, pos = idx >> 4, fi = idx & 15; const float inv = 1.0f / powf(10000.0f, (float)fi * (1.0f / 16.0f)); const float ang = (float)pos * inv;
              ((float*)(ws + WS_ROPE))[idx] = cosf(ang); ((float*)(ws + WS_ROPE))[1024 + idx] = sinf(ang); }
        }
    }
    SEAM(0);
    { GET_LANE();
      if (tid == 0) { unsigned ok = (hi - lo > 1 && G == 256) ? 1u : 0u; const unsigned* bw = (const unsigned*)(ARG_WS() + WS_BAR);
          for (unsigned j = 0; j < 16; ++j) { const unsigned c = xb_ld((unsigned*)&bw[XB_XCNT(j)]); if (c != (j < 8 ? (unsigned)(G >> 3) : 0u)) ok = 0u; }
          ((volatile LAS unsigned*)(lds + LDSCTL_OFF))[3] = ok; }
      __syncthreads(); }
    const bool grouped = __builtin_amdgcn_readfirstlane(((volatile LAS unsigned*)(lds + LDSCTL_OFF))[3]) != 0u;
    const int gx = grouped ? (int)xcc : (bx & 7), gl = grouped ? (int)__builtin_amdgcn_readfirstlane(((volatile LAS unsigned*)(lds + LDSCTL_OFF))[2]) : (bx >> 3);
    const int cv = gl * 8 + gx;
    const int vcu2 = grouped ? gx * (G >> 3) + gl : vcu;
#define GSEAM(k) do { if (IN(k) && IN((k) + 1)) { GET_LANE(); if (grouped) grp_barrier((unsigned*)(ARG_WS() + WS_BAR) + XCD_BAR_WORDS, (unsigned)gx, (unsigned)(G >> 3), tid); \
        else xcd_barrier((unsigned*)(ARG_WS() + WS_BAR), xcc, (volatile LAS unsigned*)(lds + LDSCTL_OFF), (unsigned)G, tid); } } while (0)

    if (IN(1)) for (int rep = 0; rep < NREP(1); ++rep) {
        GET_LANE();
        unsigned char* const ws = ARG_WS();
        const float* mod = (const float*)(ws + WS_MOD); bf16_t* Hb = (bf16_t*)(ws + WS_H);
        const float* x = ARGP(I_X); const float* ctx = ARGP(I_CTX); const float* ng = ARGP(I_N1G);
#define P1_ROW(mrow) do { \
            const float* xr = (mrow < ML) ? x + (size_t)mrow * DM : ctx + (size_t)(mrow - ML) * DM; \
            const float* mr = mod + (size_t)((mrow < ML) ? (mrow >> 12) : 8) * NMOD; \
            f32x4 v[4]; float s = 0.f; \
            _Pragma("unroll") \
            for (int j = 0; j < 4; ++j) { v[j] = *(const f32x4*)(xr + 512 * (j >> 1) + 8 * lane + 4 * (j & 1)); s += (v[j][0] * v[j][0] + v[j][1] * v[j][1]) + (v[j][2] * v[j][2] + v[j][3] * v[j][3]); } \
            const float rinv = rsqrtf(wave_sum(s) * (1.0f / DM) + EPS); \
            _Pragma("unroll") \
            for (int jj = 0; jj < 2; ++jj) { u32x4 w; \
            _Pragma("unroll") \
                for (int h = 0; h < 2; ++h) { const int col = 512 * jj + 8 * lane + 4 * h; const f32x4 g = *(const f32x4*)(ng + col), sh = *(const f32x4*)(mr + col), sc = *(const f32x4*)(mr + DM + col); \
                    const f32x4 o = (v[2 * jj + h] * rinv * g) * (sc + 1.0f) + sh; if (h == 0) { w.x = cvtpk(o[0], o[1]); w.y = cvtpk(o[2], o[3]); } else { w.z = cvtpk(o[0], o[1]); w.w = cvtpk(o[2], o[3]); } } \
                *(u32x4*)(Hb + (size_t)mrow * DM + 512 * jj + 8 * lane) = w; } \
        } while (0)
        { const int nrow = grouped ? (4 * SEQ + 4 * CTXL) : MT;
          for (int r = gw; r < nrow; r += NGW) { const int mrow = (!grouped || r < 4 * SEQ) ? r : ML + (r - 4 * SEQ); P1_ROW(mrow); } }
        { const bf16_t* Wgu = (const bf16_t*)(ws + WS_WGU); float* beta = (float*)(ws + WS_BETA);
          f32x4 sh[8][4];
#pragma unroll
          for (int bb = 0; bb < 8; ++bb)
#pragma unroll
              for (int q = 0; q < 4; ++q) sh[bb][q] = *(const f32x4*)(mod + (size_t)bb * NMOD + 3 * DM + lane * 16 + 4 * q);
          for (int it = gw; it < 2 * FFH; it += NGW) {
              const u32x4 wa = *(const u32x4*)(Wgu + (size_t)it * DM + lane * 16), wb = *(const u32x4*)(Wgu + (size_t)it * DM + lane * 16 + 8);
              f32x4 wf[4];
              wf[0] = (f32x4){__uint_as_float(wa[0] << 16), __uint_as_float(wa[0] & 0xffff0000u), __uint_as_float(wa[1] << 16), __uint_as_float(wa[1] & 0xffff0000u)};
              wf[1] = (f32x4){__uint_as_float(wa[2] << 16), __uint_as_float(wa[2] & 0xffff0000u), __uint_as_float(wa[3] << 16), __uint_as_float(wa[3] & 0xffff0000u)};
              wf[2] = (f32x4){__uint_as_float(wb[0] << 16), __uint_as_float(wb[0] & 0xffff0000u), __uint_as_float(wb[1] << 16), __uint_as_float(wb[1] & 0xffff0000u)};
              wf[3] = (f32x4){__uint_as_float(wb[2] << 16), __uint_as_float(wb[2] & 0xffff0000u), __uint_as_float(wb[3] << 16), __uint_as_float(wb[3] & 0xffff0000u)};
              float a[8];
#pragma unroll
              for (int bb = 0; bb < 8; ++bb) { f32x4 t = sh[bb][0] * wf[0] + sh[bb][1] * wf[1] + sh[bb][2] * wf[2] + sh[bb][3] * wf[3]; a[bb] = (t[0] + t[1]) + (t[2] + t[3]); }
              const bool c0 = lane & 1, c1 = lane & 2, c2 = lane & 4;
              float p[4], q2[2], r1;
#pragma unroll
              for (int i = 0; i < 4; ++i) { const float keep = c0 ? a[i + 4] : a[i], send = c0 ? a[i] : a[i + 4]; p[i] = keep + __shfl_xor(send, 1); }
#pragma unroll
              for (int i = 0; i < 2; ++i) { const float keep = c1 ? p[i + 2] : p[i], send = c1 ? p[i] : p[i + 2]; q2[i] = keep + __shfl_xor(send, 2); }
              { const float keep = c2 ? q2[1] : q2[0], send = c2 ? q2[0] : q2[1]; r1 = keep + __shfl_xor(send, 4); }
              r1 += __shfl_xor(r1, 8); r1 += __shfl_xor(r1, 16); r1 += __shfl_xor(r1, 32);
              if (lane < 8) { const int bb = 4 * (lane & 1) + 2 * ((lane >> 1) & 1) + ((lane >> 2) & 1); beta[(size_t)bb * (2 * FFH) + it] = r1; }
          } }
    }
    SEAM(1);
    if (IN(1) && IN(2) && grouped && gx >= 4) {
        GET_LANE();
        unsigned char* const ws = ARG_WS();
        const float* mod = (const float*)(ws + WS_MOD); bf16_t* Hb = (bf16_t*)(ws + WS_H);
        const float* x = ARGP(I_X); const float* ctx = ARGP(I_CTX); const float* ng = ARGP(I_N1G);
        const int nlw = (G >> 3) * NWAVES;
        for (int r = gl * NWAVES + wave; r < SEQ + CTXL; r += nlw) { const int mrow = (r < SEQ) ? gx * SEQ + r : ML + gx * CTXL + (r - SEQ); P1_ROW(mrow); }
        grp_barrier((unsigned*)(ARG_WS() + WS_BAR) + XCD_BAR_WORDS, (unsigned)gx, (unsigned)(G >> 3), tid);
    }
#undef P1_ROW

    if (IN(2)) for (int rep = 0; rep < NREP(2); ++rep) {
        unsigned char* const ws = ARG_WS();
        pg8::Gemm g{(const bf16_t*)(ws + WS_H), (const bf16_t*)(ws + WS_WIN), MT, INC, DM};
        pg8::EpiInProj E{(bf16_t*)(ws + WS_QKV), (const float*)(ws + WS_GAINS), (const float*)(ws + WS_ROPE), (const float*)(ws + WS_ROPE) + 1024};
        if (grouped) { pg8::BatchOrder S{gx, gl, G >> 3}; pg8::gemm_phase<pg8::EpiInProj, pg8::BatchOrder>(lds, lds + LDX_OFF, g, S, E, wave); }
        else { pg8::StaticOrder S; S.init(MT, INC, G, bx); pg8::gemm_phase<pg8::EpiInProj, pg8::StaticOrder>(lds, lds + LDX_OFF, g, S, E, wave); }
    }
    GSEAM(2);

    if (IN(3)) for (int rep = 0; rep < NREP(3); ++rep) {
        GET_LANE();
        unsigned char* const ws = ARG_WS();
        const bf16_t* QKV = (const bf16_t*)(ws + WS_QKV); bf16_t* Ob = (bf16_t*)(ws + WS_O); float* ssq1 = (float*)(ws + (FIRST_OF_2(3) ? WS_DUMMY : WS_SSQ1));
        const float* sinkp = ARGP(I_SINK); const float* rpbp = ARGP(I_RPB);
        const int per = (1024 + G - 1) / G;
        const float MA = ((const float*)(ws + WS_BOUNDS))[0], MB = ((const float*)(ws + WS_BOUNDS))[1];
        const bool fixA = MA < 48.0f, fixB = MB < 48.0f;
        for (int i = 0; i < per; ++i) { const int ua = vcu2 * per + i; if (ua < 1024) { if (fixA) att::attn_unit<0, true>(lds, QKV, Ob, ssq1, sinkp, rpbp, ua, tid, lane, wave, MA); else att::attn_unit<0, false>(lds, QKV, Ob, ssq1, sinkp, rpbp, ua, tid, lane, wave, 0.f); } }
        for (int i = 0; i < per; ++i) { const int ub = (G == 256) ? ((vcu2 >> 5) * 128 + i * 32 + (vcu2 & 31)) : (vcu2 * per + i);
            if (ub < 1024) { if (fixB) att::attn_unit<1, true>(lds, QKV, Ob, ssq1, sinkp, rpbp, ub, tid, lane, wave, MB); else att::attn_unit<1, false>(lds, QKV, Ob, ssq1, sinkp, rpbp, ub, tid, lane, wave, 0.f); } }
    }
    GSEAM(3);

    if (IN(4)) for (int rep = 0; rep < NREP(4); ++rep) {
        unsigned char* const ws = ARG_WS();
        pg8::Gemm g{(const bf16_t*)(ws + WS_O), (const bf16_t*)(ws + WS_WOUT), ML, DM, DM}; pg8::StaticOrder S; S.init(ML, DM, G, cv);
        pg8::EpiOutProj E{ARGP(I_X), (bf16_t*)(ws + WS_QKV), (const float*)(ws + WS_SSQ1), (float*)(ws + (FIRST_OF_2(4) ? WS_DUMMY : WS_SSQ2)), (const float*)(ws + WS_MOD), (bf16_t*)(ws + WS_H), ARGP(I_N2G)};
        pg8::gemm_phase<pg8::EpiOutProj, pg8::StaticOrder>(lds, lds + LDX_OFF, g, S, E, wave);
    }
    GSEAM(4);

    if (IN(6)) for (int rep = 0; rep < NREP(6); ++rep) {
        unsigned char* const ws = ARG_WS();
        pg8::Gemm g{(const bf16_t*)(ws + WS_H), (const bf16_t*)(ws + WS_WGU), ML, 2 * FFH, DM}; pg8::StaticOrder S; S.init(ML, 2 * FFH, G, cv);
        pg8::EpiGateUp E{(bf16_t*)(ws + WS_HID), (const float*)(ws + WS_SSQ2), (const float*)(ws + WS_BETA)};
        pg8::gemm_phase<pg8::EpiGateUp, pg8::StaticOrder>(lds, lds + LDX_OFF, g, S, E, wave);
    }
    GSEAM(6);

    if (IN(7)) for (int rep = 0; rep < NREP(7); ++rep) {
        unsigned char* const ws = ARG_WS();
        pg8::Gemm g{(const bf16_t*)(ws + WS_HID), (const bf16_t*)(ws + WS_WDN), ML, DM, FFH}; pg8::StaticOrder S; S.init(ML, DM, G, cv);
        pg8::EpiDown E{(const bf16_t*)(ws + WS_QKV), FIRST_OF_2(7) ? (float*)(ws + WS_O) : ARG_OUT(), (const float*)(ws + WS_MOD)};
        pg8::gemm_phase<pg8::EpiDown, pg8::StaticOrder>(lds, lds + LDX_OFF, g, S, E, wave);
    }
#undef IN
#undef SEAM
#undef ARGP
#undef ARG_OUT
#undef ARG_WS
#undef GET_LANE
}

extern "C" void kernel_launch(void* const* d_in, const int* in_sizes, int n_in, void* d_out, int out_size, void* d_ws, size_t ws_size, hipStream_t stream) {
    static int grid = 0;
    if (grid == 0) {
        if (n_in != 21 || in_sizes[0] != ML * DM || out_size != ML * DM || ws_size < WS_END) { fprintf(stderr, "kernel_launch: unexpected shapes (n_in %d in0 %d out %d ws %zu)\n", n_in, n_in > 0 ? in_sizes[0] : -1, out_size, ws_size); grid = -1; return; }
        int dev = 0, cus = 0, per_cu = 0;
        hipGetDevice(&dev); hipDeviceGetAttribute(&cus, hipDeviceAttributeMultiprocessorCount, dev);
        hipFuncSetAttribute((const void*)fwd_kernel, hipFuncAttributeMaxDynamicSharedMemorySize, LDS_BYTES);
        if (hipOccupancyMaxActiveBlocksPerMultiprocessor(&per_cu, (const void*)fwd_kernel, NWAVES * 64, LDS_BYTES) != hipSuccess || per_cu < 1) { fprintf(stderr, "kernel_launch: occupancy query says %d\n", per_cu); per_cu = 1; }
        (void)hipGetLastError();
        grid = cus;
    }
    if (grid < 0) return;
    hipMemsetAsync((char*)d_ws, 0, WS_ZERO_BYTES, stream);
    Args a{};
    for (int i = 0; i < 21; ++i) a.in[i] = (const float*)d_in[i];
    a.out = (float*)d_out; a.ws = (unsigned char*)d_ws;
#if MK_N_LAUNCHES == 1
    a.ph_lo = 0; a.ph_hi = 8;
    void* kargs[] = {&a};
    hipError_t e = hipLaunchCooperativeKernel((const void*)fwd_kernel, dim3(grid), dim3(NWAVES * 64), kargs, LDS_BYTES, stream);
    if (e != hipSuccess) fprintf(stderr, "cooperative launch failed: %s (grid %d)\n", hipGetErrorString(e), grid);
#else
    for (int p = 0; p < 8; ++p) { a.ph_lo = p; a.ph_hi = p + 1; hipLaunchKernelGGL(fwd_kernel, dim3(grid), dim3(NWAVES * 64), LDS_BYTES, stream, a); }
#endif
}
```

```cpp
#include <hip/hip_runtime.h>
#include <hip/hip_cooperative_groups.h>
#include <cstdio>
#include <cstdint>
namespace cg = cooperative_groups;

#ifndef MK_N_LAUNCHES
#define MK_N_LAUNCHES 1
#endif

#define LAS __attribute__((address_space(3)))
typedef unsigned short bf16_t;
typedef short bf16x8 __attribute__((ext_vector_type(8)));
typedef short s16x4 __attribute__((ext_vector_type(4)));
typedef float f32x2 __attribute__((ext_vector_type(2)));
typedef float f32x4 __attribute__((ext_vector_type(4)));
typedef float f32x16 __attribute__((ext_vector_type(16)));
typedef unsigned u32x2 __attribute__((ext_vector_type(2)));
typedef unsigned u32x4 __attribute__((ext_vector_type(4)));
typedef __bf16 bf16x2_t __attribute__((ext_vector_type(2)));

constexpr int DM = 1024, NB = 8, SEQ = 4096, CTXL = 256, ML = NB * SEQ, MC = NB * CTXL, MT = ML + MC;
constexpr int INC = 2304, FFH = 2816, NMOD = 6144;
constexpr float EPS = 1e-6f;
constexpr float LOG2E = 1.4426950408889634f;
constexpr float C2 = 0.125f * LOG2E;
constexpr int NWAVES = 8;

constexpr size_t MiB = 1u << 20, KiB = 1u << 10;
constexpr size_t WS_MOD = 0;
constexpr size_t WS_SSQ1 = 256 * KiB;
constexpr size_t WS_SSQ2 = 512 * KiB;
constexpr size_t WS_BAR = 640 * KiB;
constexpr size_t WS_ZERO_BYTES = 672 * KiB;
constexpr size_t WS_ROPE = 768 * KiB;
constexpr size_t WS_GAINS = 776 * KiB;
constexpr size_t WS_BOUNDS = 780 * KiB;
constexpr size_t WS_BETA = 800 * KiB;
constexpr size_t WS_WIN = 2 * MiB, WS_WOUT = 7 * MiB, WS_WGU = 9 * MiB, WS_WDN = 20 * MiB;
constexpr size_t WS_H = 32 * MiB;
constexpr size_t WS_QKV = 100 * MiB;
constexpr size_t WS_O = 256 * MiB;
constexpr size_t WS_HID = 320 * MiB;
constexpr size_t WS_DUMMY = 496 * MiB;
constexpr size_t WS_END = 497 * MiB;

constexpr int RING_BYTES = 131072, LDX_OFF = RING_BYTES, LDSCTL_OFF = LDX_OFF + 8192, LDS_BYTES = 147456;

__device__ __forceinline__ unsigned cvtpk(float lo, float hi) { f32x2 v = {lo, hi}; bf16x2_t b = __builtin_convertvector(v, bf16x2_t); return __builtin_bit_cast(unsigned, b); }
__device__ __forceinline__ float wave_sum(float v) {
#pragma unroll
    for (int o = 1; o < 64; o <<= 1) v += __shfl_xor(v, o);
    return v;
}
__device__ __forceinline__ float swap_max(float v) { auto rr = __builtin_amdgcn_permlane32_swap(__float_as_uint(v), __float_as_uint(v), false, false); return fmaxf(__uint_as_float(rr[0]), __uint_as_float(rr[1])); }
__device__ __forceinline__ float fq_sum(float v) {
    auto a = __builtin_amdgcn_permlane16_swap(__float_as_uint(v), __float_as_uint(v), false, false); v = __uint_as_float(a[0]) + __uint_as_float(a[1]);
    auto b = __builtin_amdgcn_permlane32_swap(__float_as_uint(v), __float_as_uint(v), false, false); return __uint_as_float(b[0]) + __uint_as_float(b[1]); }
__device__ __forceinline__ u32x4 pair16(u32x2 a, u32x2 b) {
    auto rx = __builtin_amdgcn_permlane16_swap(a.x, b.x, false, false);
    auto ry = __builtin_amdgcn_permlane16_swap(a.y, b.y, false, false);
    u32x4 r; r.x = rx[0]; r.y = ry[0]; r.z = rx[1]; r.w = ry[1]; return r;
}
__device__ __forceinline__ float swap_sum(float v) { auto rr = __builtin_amdgcn_permlane32_swap(__float_as_uint(v), __float_as_uint(v), false, false); return __uint_as_float(rr[0]) + __uint_as_float(rr[1]); }

namespace pg8 {
#define PG8_LAS __attribute__((address_space(3)))
constexpr int BM = 256, BK = 64, HALF = 128, HTB = HALF * BK * 2, STAGE_BYTES = 8 * HTB, NXCD = 8, WGM = 8;
__host__ __device__ __forceinline__ int lds_byte(int r, int c) { const int st = (r >> 4) * 2 + (c >> 5), rr = r & 15, cc = c & 31, ob = rr * 64 + cc * 2; return st * 1024 + (ob ^ (((ob >> 9) & 1) << 5)); }
__host__ __device__ __forceinline__ void stage_rc(int b, int& R, int& C) { const int st = b / 1024, sb = b % 1024, swz = sb ^ (((sb >> 9) & 1) << 5); R = (st >> 1) * 16 + swz / 64; C = (st & 1) * 32 + (swz % 64) / 2; }
__host__ __device__ __forceinline__ int perm32(int rho) { const int n = rho >> 4, i = rho & 15; return 8 * (i >> 2) + 4 * n + (i & 3); }
struct Unit { int pm, pn; };
struct Gemm { const bf16_t* A; const bf16_t* Bt; int M, N, K; };
struct StaticOrder {
    int nM, nN, nwg, G, c;
    __host__ __device__ void init(int M, int N, int G_, int c_) { nM = M / BM; nN = N / BM; nwg = nM * nN; G = G_; c = c_; }
    __host__ __device__ bool next(int i, Unit& u) const {
        const long L = (long)i * G + c; if (L >= nwg) return false;
        int wgid = (int)L; { const int q = nwg / NXCD, r = nwg % NXCD, xcd = wgid % NXCD, off = wgid / NXCD; wgid = (xcd < r ? xcd * (q + 1) : r * (q + 1) + (xcd - r) * q) + off; }
        const int nig = WGM * nN, gid = wgid / nig, fm = gid * WGM, gsz = (nM - fm) < WGM ? (nM - fm) : WGM;
        u.pm = fm + ((wgid % nig) % gsz); u.pn = (wgid % nig) / gsz; return true;
    }
    __device__ __forceinline__ void a_ready(const Unit&) const {}
    __device__ __forceinline__ void done(const Unit&) const {}
};

struct BatchOrder {
    int x, gl, nloc;
    __device__ __forceinline__ bool next(int i, Unit& u) const {
        if (nloc != 32) { const int L = i * nloc + gl; if (L >= 153) return false; const int pn = L / 17, r = L - 17 * pn; u.pn = pn; u.pm = (r < 16) ? 16 * x + r : 128 + x; return true; }
        if (i < 4) { u.pm = 16 * x + (i >> 1) * 8 + (gl & 7); u.pn = (i & 1) * 4 + (gl >> 3); return true; }
        if (i > 4 || gl >= 25) return false;
        if (gl < 16) { u.pm = 16 * x + gl; u.pn = 8; } else { u.pm = 128 + x; u.pn = gl - 16; }
        return true;
    }
};

typedef f32x4 Acc[2][2][4][2];

struct NoPre {};
struct EpiInProj {
    static constexpr bool PERM = false, HAS_MID = false;
    typedef NoPre Pre;
    __device__ __forceinline__ void prefetch(Pre&, const Unit&, int, int, int, int) const {}
    bf16_t* QKV; const float* gains; const float* ropec; const float* ropes;
    __device__ __forceinline__ void mid(Acc&, const Unit&, int, int, int, int) const {}
    __device__ __forceinline__ void operator()(Acc& acc, const Unit& u, int wr, int wc, int fr, int fq, PG8_LAS unsigned char* ldx, const Pre&) const {
        const int pn = u.pn;
        const bool normed0 = pn < 7, normed1 = normed0 && pn != 2;
        PG8_LAS float* X = (PG8_LAS float*)ldx;
        const bool latent = u.pm < (ML / 256);
        const bool isq = (pn < 2) || (pn == 3) || (pn == 4);
        const bool rope = latent && pn <= 2;
        const float* gp = gains + 64 * ((pn < 2) ? 0 : (pn == 2) ? 1 : (pn < 5) ? 2 : 3);
        const int hc = 32 * (wc & 1) + 4 * fq;
        f32x4 g0 = {1.f, 1.f, 1.f, 1.f}, g1 = {1.f, 1.f, 1.f, 1.f};
        if (normed0) { g0 = *(const f32x4*)(gp + hc); g1 = *(const f32x4*)(gp + hc + 16); }
        if (isq) { g0 = g0 * C2; g1 = g1 * C2; }
        f32x4 rc[4], rs[4];
#pragma unroll
        for (int m = 0; m < 4; ++m) { rc[m] = (f32x4){1.f, 1.f, 1.f, 1.f}; rs[m] = (f32x4){0.f, 0.f, 0.f, 0.f}; }
        if (rope) {
#pragma unroll
            for (int m = 0; m < 4; ++m) { const int pos = (wc & 1) ? (16 * m + fr) : ((4 * u.pm + wr) & 63); rc[m] = *(const f32x4*)(ropec + pos * 16 + 4 * fq); rs[m] = *(const f32x4*)(ropes + pos * 16 + 4 * fq); }
        }
        if (normed0) {
#pragma unroll
            for (int ai = 0; ai < 2; ++ai)
#pragma unroll
                for (int m = 0; m < 4; ++m)
#pragma unroll
                    for (int bj = 0; bj < 2; ++bj) {
                        if (bj == 0 || normed1) {
                            const f32x4 a = acc[ai][bj][m][0], b = acc[ai][bj][m][1];
                            float s = (a[0] * a[0] + a[1] * a[1]) + (a[2] * a[2] + a[3] * a[3]) + (b[0] * b[0] + b[1] * b[1]) + (b[2] * b[2] + b[3] * b[3]);
                            s = fq_sum(s);
                            if (fq == 0) X[((ai * 128 + wr * 64 + m * 16 + fr) * 2 + bj) * 4 + wc] = s;
                        }
                    }
            asm volatile("s_waitcnt lgkmcnt(0)" ::: "memory"); __builtin_amdgcn_s_barrier(); asm volatile("" ::: "memory");
        }
#pragma unroll
        for (int ai = 0; ai < 2; ++ai) {
            if (ai == 1 && rope && !(wc & 1)) {
#pragma unroll
                for (int m = 0; m < 4; ++m) { const int pos = (4 * u.pm + 2 + wr) & 63; rc[m] = *(const f32x4*)(ropec + pos * 16 + 4 * fq); rs[m] = *(const f32x4*)(ropes + pos * 16 + 4 * fq); }
            }
#pragma unroll
            for (int m = 0; m < 4; ++m) {
                const int rowl = ai * 128 + wr * 64 + m * 16 + fr;
                const size_t grow = (size_t)u.pm * 256 + rowl;
                const f32x4 cs = rc[m], sn = rs[m];
#pragma unroll
                for (int bj = 0; bj < 2; ++bj) {
                    const bool normed = bj == 0 ? normed0 : normed1;
                    f32x4 v0 = acc[ai][bj][m][0], v1 = acc[ai][bj][m][1];
                    if (normed) {
                        const f32x2 pr = *(const PG8_LAS f32x2*)(X + (rowl * 2 + bj) * 4 + (wc & 2));
                        const float rinv = rsqrtf((pr.x + pr.y) * (1.0f / 64.0f) + EPS);
                        v0 = v0 * rinv * g0; v1 = v1 * rinv * g1;
                        if (rope) { const f32x4 t0 = v0 * cs - v1 * sn, t1 = v0 * sn + v1 * cs; v0 = t0; v1 = t1; }
                    }
                    bf16_t* p = QKV + grow * INC + pn * 256 + bj * 128 + wc * 32 + ((fq & 1) ? 16 + 4 * (fq - 1) : 4 * fq);
                    u32x2 w0, w1; w0.x = cvtpk(v0[0], v0[1]); w0.y = cvtpk(v0[2], v0[3]); w1.x = cvtpk(v1[0], v1[1]); w1.y = cvtpk(v1[2], v1[3]);
                    *(u32x4*)p = pair16(w0, w1);
                }
                asm volatile("" ::: "memory");
            }
        }
    }
};

struct EpiOutProj {
    static constexpr bool PERM = false, HAS_MID = true;
    typedef NoPre Pre;
    __device__ __forceinline__ void prefetch(Pre&, const Unit&, int, int, int, int) const {}
    const float* x; bf16_t* XN; const float* ssq1; float* ssq2; const float* mod; bf16_t* A2; const float* n2g;
    __device__ __forceinline__ void mid(Acc& acc, const Unit& u, int wr, int wc, int fr, int fq) const {
#pragma unroll
        for (int ai = 0; ai < 2; ++ai)
#pragma unroll
            for (int m = 0; m < 4; ++m) {
                const int row = u.pm * 256 + ai * 128 + wr * 64 + m * 16 + fr;
                const f32x2 s = *(const f32x2*)(ssq1 + 2 * (size_t)row);
                const float f = rsqrtf(s.x * (1.0f / 512.0f) + EPS) * sqrtf(s.y * (1.0f / 512.0f) + EPS);
#pragma unroll
                for (int bj = 0; bj < 2; ++bj)
#pragma unroll
                    for (int n = 0; n < 2; ++n) acc[ai][bj][m][n] = acc[ai][bj][m][n] * f;
            }
    }
    __device__ __forceinline__ void operator()(Acc& acc, const Unit& u, int wr, int wc, int fr, int fq, PG8_LAS unsigned char*, const Pre&) const {
        const int b = (u.pm * 256) >> 12;
        const int col0 = u.pn * 256 + wc * 32 + 4 * fq;
        const float* g1p = mod + (size_t)b * NMOD + 2 * DM + col0;
#pragma unroll
        for (int ai = 0; ai < 2; ++ai) {
            f32x4 xv[4][2][2]; float sb[4], ss[4];
#pragma unroll
            for (int m = 0; m < 4; ++m) { const int row = u.pm * 256 + ai * 128 + wr * 64 + m * 16 + fr; sb[m] = ssq1[2 * (size_t)row + 1]; ss[m] = 0.f;
#pragma unroll
                for (int bj = 0; bj < 2; ++bj)
#pragma unroll
                    for (int n = 0; n < 2; ++n) xv[m][bj][n] = *(const f32x4*)(x + (size_t)row * DM + col0 + bj * 128 + n * 16); }
#pragma unroll
            for (int m = 0; m < 4; ++m) sb[m] = rsqrtf(sb[m] * (1.0f / 512.0f) + EPS);
            const int col_st = u.pn * 256 + wc * 32 + ((fq & 1) ? 16 + 4 * (fq - 1) : 4 * fq);
#pragma unroll
            for (int bj = 0; bj < 2; ++bj) {
                const f32x4 gv0 = *(const f32x4*)(g1p + bj * 128), gv1 = *(const f32x4*)(g1p + bj * 128 + 16);
                const f32x4 gm0 = *(const f32x4*)(n2g + col0 + bj * 128) * (*(const f32x4*)(g1p + 2 * DM + bj * 128) + 1.0f);
                const f32x4 gm1 = *(const f32x4*)(n2g + col0 + bj * 128 + 16) * (*(const f32x4*)(g1p + 2 * DM + bj * 128 + 16) + 1.0f);
#pragma unroll
                for (int m = 0; m < 4; ++m) {
                    const int row = u.pm * 256 + ai * 128 + wr * 64 + m * 16 + fr;
                    const f32x4 o0 = xv[m][bj][0] + gv0 * (acc[ai][bj][m][0] * sb[m]), o1 = xv[m][bj][1] + gv1 * (acc[ai][bj][m][1] * sb[m]);
                    ss[m] += ((o0[0] * o0[0] + o0[1] * o0[1]) + (o0[2] * o0[2] + o0[3] * o0[3])) + ((o1[0] * o1[0] + o1[1] * o1[1]) + (o1[2] * o1[2] + o1[3] * o1[3]));
                    const f32x4 a0 = o0 * gm0, a1 = o1 * gm1;
                    u32x2 x0, x1, y0, y1;
                    x0.x = cvtpk(o0[0], o0[1]); x0.y = cvtpk(o0[2], o0[3]); x1.x = cvtpk(o1[0], o1[1]); x1.y = cvtpk(o1[2], o1[3]);
                    y0.x = cvtpk(a0[0], a0[1]); y0.y = cvtpk(a0[2], a0[3]); y1.x = cvtpk(a1[0], a1[1]); y1.y = cvtpk(a1[2], a1[3]);
                    const size_t off = (size_t)row * DM + col_st + bj * 128;
                    *(u32x4*)(XN + (size_t)b * (SEQ * (INC - DM)) + off) = pair16(x0, x1);
                    *(u32x4*)(A2 + off) = pair16(y0, y1);
                }
            }
#pragma unroll
            for (int m = 0; m < 4; ++m) { const int row = u.pm * 256 + ai * 128 + wr * 64 + m * 16 + fr; float t = fq_sum(ss[m]); if (fq == 0) atomicAdd(ssq2 + row, t); }
            asm volatile("" ::: "memory");
        }
    }
};

struct EpiGateUp {
    static constexpr bool PERM = true, HAS_MID = false;
    bf16_t* HID; const float* ssq2; const float* beta;
    struct Pre { f32x4 bg[2], bu[2]; float r2[2][4]; };
    __device__ __forceinline__ void prefetch(Pre& P, const Unit& u, int wr, int wc, int fr, int fq) const {
        const float* bp = beta + (size_t)((u.pm * 256) >> 12) * (2 * FFH) + u.pn * 256 + wc * 32 + 8 * fq;
#pragma unroll
        for (int n = 0; n < 2; ++n) { P.bg[n] = *(const f32x4*)(bp + 4 * n); P.bu[n] = *(const f32x4*)(bp + 128 + 4 * n); }
#pragma unroll
        for (int ai = 0; ai < 2; ++ai)
#pragma unroll
            for (int m = 0; m < 4; ++m) P.r2[ai][m] = ssq2[u.pm * 256 + ai * 128 + wr * 64 + m * 16 + fr];
    }
    __device__ __forceinline__ void mid(Acc&, const Unit&, int, int, int, int) const {}
    __device__ __forceinline__ void operator()(Acc& acc, const Unit& u, int wr, int wc, int fr, int fq, PG8_LAS unsigned char*, const Pre& P) const {
        const int col0 = u.pn * 128 + wc * 32 + 8 * fq;
#pragma unroll
        for (int ai = 0; ai < 2; ++ai)
#pragma unroll
            for (int m = 0; m < 4; ++m) {
                const int row = u.pm * 256 + ai * 128 + wr * 64 + m * 16 + fr;
                const float r2 = rsqrtf(P.r2[ai][m] * (1.0f / DM) + EPS);
                float h[8];
#pragma unroll
                for (int n = 0; n < 2; ++n)
#pragma unroll
                    for (int j = 0; j < 4; ++j) { const float g = acc[ai][0][m][n][j] * r2 + P.bg[n][j], up = acc[ai][1][m][n][j] * r2 + P.bu[n][j];
                        h[n * 4 + j] = g * __builtin_amdgcn_rcpf(1.0f + __builtin_amdgcn_exp2f(-g * LOG2E)) * up; }
                u32x4 w; w.x = cvtpk(h[0], h[1]); w.y = cvtpk(h[2], h[3]); w.z = cvtpk(h[4], h[5]); w.w = cvtpk(h[6], h[7]);
                *(u32x4*)(HID + (size_t)row * FFH + col0) = w;
            }
    }
};

struct EpiDown {
    static constexpr bool PERM = false, HAS_MID = false;
    const bf16_t* src; float* out; const float* mod;
    struct Pre { f32x4 gv[2][2]; };
    __device__ __forceinline__ void prefetch(Pre& P, const Unit& u, int wr, int wc, int fr, int fq) const {
        const float* g2p = mod + (size_t)((u.pm * 256) >> 12) * NMOD + 5 * DM + u.pn * 256 + wc * 32 + 4 * fq;
#pragma unroll
        for (int bj = 0; bj < 2; ++bj)
#pragma unroll
            for (int n = 0; n < 2; ++n) P.gv[bj][n] = *(const f32x4*)(g2p + bj * 128 + n * 16);
    }
    __device__ __forceinline__ void mid(Acc&, const Unit&, int, int, int, int) const {}
    __device__ __forceinline__ void operator()(Acc& acc, const Unit& u, int wr, int wc, int fr, int fq, PG8_LAS unsigned char*, const Pre& P) const {
        const int col0 = u.pn * 256 + wc * 32 + 4 * fq;
#pragma unroll
        for (int ai = 0; ai < 2; ++ai) {
            u32x2 xv[4][2][2];
#pragma unroll
            for (int m = 0; m < 4; ++m) { const int row = u.pm * 256 + ai * 128 + wr * 64 + m * 16 + fr;
#pragma unroll
                for (int bj = 0; bj < 2; ++bj)
#pragma unroll
                    for (int n = 0; n < 2; ++n) xv[m][bj][n] = *(const u32x2*)(src + (size_t)((u.pm * 256) >> 12) * (SEQ * (INC - DM)) + (size_t)row * DM + col0 + bj * 128 + n * 16); }
#pragma unroll
            for (int m = 0; m < 4; ++m) {
                const int row = u.pm * 256 + ai * 128 + wr * 64 + m * 16 + fr;
#pragma unroll
                for (int bj = 0; bj < 2; ++bj)
#pragma unroll
                    for (int n = 0; n < 2; ++n) { const u32x2 w = xv[m][bj][n]; const f32x4 xf = {__uint_as_float(w.x << 16), __uint_as_float(w.x & 0xffff0000u), __uint_as_float(w.y << 16), __uint_as_float(w.y & 0xffff0000u)};
                        *(f32x4*)(out + (size_t)row * DM + col0 + bj * 128 + n * 16) = xf + P.gv[bj][n] * acc[ai][bj][m][n]; }
            }
            asm volatile("" ::: "memory");
        }
    }
};

template <class Epi, class Sched>
__device__ __forceinline__ void gemm_phase(PG8_LAS unsigned char* lds, PG8_LAS unsigned char* ldx, const Gemm g, const Sched& S, const Epi& E, const int wid) {
    int lane; asm volatile("v_mbcnt_lo_u32_b32 %0, -1, 0\n\tv_mbcnt_hi_u32_b32 %0, -1, %0" : "=v"(lane)); const int tid = wid * 64 + lane;
    const int wr = wid >> 2, wc = wid & 3, fr = lane & 15, fq = lane >> 4;
    const int K = g.K, nt = K / BK;
    unsigned voffA[2], voffB[2];
#pragma unroll
    for (int i = 0; i < 2; ++i) { int R, C; stage_rc(tid * 16 + i * 8192, R, C); const int Rb = Epi::PERM ? ((R & ~31) + perm32(R & 31)) : R;
        voffA[i] = (unsigned)(R * K + C) * 2u; voffB[i] = (unsigned)(Rb * K + C) * 2u; }
    const size_t kstep = (size_t)(BK * 2);
    const size_t hstep = (size_t)HALF * K * 2;
    const size_t tstep = 2 * hstep;
    const unsigned ldsw = (unsigned)wid * 1024u;
    const int aoff = lds_byte(wr * 64 + fr, fq * 8), boff = lds_byte(wc * 32 + fr, fq * 8);
#define PG8_SA(b, h) (((b) * 2 + (h)) * HTB)
#define PG8_SB(b, h) ((4 + (b) * 2 + (h)) * HTB)
#define PG8_STAGE(bufoff, gbase, voff) do { _Pragma("unroll") for (int _i = 0; _i < 2; ++_i) \
        __builtin_amdgcn_global_load_lds((const unsigned*)((const char*)(gbase) + (voff)[_i]), (PG8_LAS unsigned*)(lds + (bufoff) + ldsw + _i * 8192), 16, 0, 0); } while (0)
#define PG8_LDA(dst, b, h) do { _Pragma("unroll") for (int m = 0; m < 4; ++m) _Pragma("unroll") for (int k = 0; k < 2; ++k) dst[m][k] = *(const PG8_LAS bf16x8*)(lds + PG8_SA(b, h) + aoff + m * 2048 + k * 1024); } while (0)
#define PG8_LDB(dst, b, h) do { _Pragma("unroll") for (int n = 0; n < 2; ++n) _Pragma("unroll") for (int k = 0; k < 2; ++k) dst[n][k] = *(const PG8_LAS bf16x8*)(lds + PG8_SB(b, h) + boff + n * 2048 + k * 1024); } while (0)
#define PG8_MMA(ai, bj, At, Bt) do { __builtin_amdgcn_s_setprio(1); _Pragma("unroll") for (int m = 0; m < 4; ++m) _Pragma("unroll") for (int n = 0; n < 2; ++n) _Pragma("unroll") for (int k = 0; k < 2; ++k) \
        acc[ai][bj][m][n] = __builtin_amdgcn_mfma_f32_16x16x32_bf16(Bt[n][k], At[m][k], acc[ai][bj][m][n], 0, 0, 0); __builtin_amdgcn_s_setprio(0); } while (0)
#define PG8_WAIT_V(n) asm volatile("s_waitcnt vmcnt(" #n ")" ::: "memory")
#define PG8_WAIT_L(n) asm volatile("s_waitcnt lgkmcnt(" #n ")" ::: "memory")
#define PG8_BAR __builtin_amdgcn_s_barrier()
#define PG8_SCHED __builtin_amdgcn_sched_barrier(0)
    Unit cur, nxt; int ui = 0;
    if (!S.next(0, cur)) return;
    Acc acc;
#pragma unroll
    for (int a = 0; a < 2; ++a)
#pragma unroll
        for (int b = 0; b < 2; ++b)
#pragma unroll
            for (int m = 0; m < 4; ++m)
#pragma unroll
                for (int n = 0; n < 2; ++n) acc[a][b][m][n] = (f32x4){0.f, 0.f, 0.f, 0.f};
    bf16x8 At[4][2], B0[2][2], B1[2][2];
    const char* cA = (const char*)g.A + (size_t)cur.pm * tstep; const char* cB = (const char*)g.Bt + (size_t)cur.pn * tstep;
    typename Epi::Pre pre; E.prefetch(pre, cur, wr, wc, fr, fq);
    PG8_STAGE(PG8_SB(0, 0), cB, voffB); PG8_STAGE(PG8_SB(0, 1), cB + hstep, voffB); PG8_STAGE(PG8_SA(0, 0), cA, voffA); PG8_STAGE(PG8_SA(0, 1), cA + hstep, voffA);
    if (wr == 1) PG8_BAR;
    PG8_WAIT_V(2); PG8_BAR;
    PG8_STAGE(PG8_SB(1, 0), cB + kstep, voffB); PG8_STAGE(PG8_SA(1, 0), cA + kstep, voffA); PG8_STAGE(PG8_SB(1, 1), cB + hstep + kstep, voffB);
    PG8_WAIT_V(6); PG8_BAR;
    for (;;) {
        const bool has_next = S.next(ui + 1, nxt);
        const char* nA = has_next ? (const char*)g.A + (size_t)nxt.pm * tstep : cA; const char* nB = has_next ? (const char*)g.Bt + (size_t)nxt.pn * tstep : cB;
        for (int t = 0; t < nt; t += 2) {
            const bool last = (t == nt - 2);
            const char* a1 = cA + (size_t)(t + 1) * kstep;
            const char* a2 = last ? nA : cA + (size_t)(t + 2) * kstep; const char* b2 = last ? nB : cB + (size_t)(t + 2) * kstep;
            const char* a3 = a2 + kstep; const char* b3 = b2 + kstep;
            if constexpr (Epi::HAS_MID) { if (t == (nt >> 1)) E.mid(acc, cur, wr, wc, fr, fq); }
            PG8_LDB(B0, 0, 0); PG8_LDB(B1, 0, 1); PG8_SCHED; PG8_LDA(At, 0, 0); PG8_STAGE(PG8_SA(1, 1), a1 + hstep, voffA);
            PG8_WAIT_V(8); PG8_WAIT_L(0); PG8_BAR; PG8_MMA(0, 0, At, B0); PG8_MMA(0, 1, At, B1); PG8_BAR; PG8_SCHED;
            PG8_LDA(At, 0, 1); PG8_STAGE(PG8_SB(0, 0), b2, voffB); PG8_STAGE(PG8_SB(0, 1), b2 + hstep, voffB); PG8_STAGE(PG8_SA(0, 0), a2, voffA);
            PG8_WAIT_V(8); PG8_WAIT_L(0); PG8_BAR; PG8_MMA(1, 0, At, B0); PG8_MMA(1, 1, At, B1); PG8_BAR; PG8_SCHED;
            PG8_LDB(B0, 1, 0); PG8_LDB(B1, 1, 1); PG8_SCHED; PG8_LDA(At, 1, 0); PG8_STAGE(PG8_SA(0, 1), a2 + hstep, voffA);
            PG8_WAIT_V(8); PG8_WAIT_L(0); PG8_BAR; PG8_MMA(0, 0, At, B0); PG8_MMA(0, 1, At, B1); PG8_BAR; PG8_SCHED;
            PG8_LDA(At, 1, 1); PG8_STAGE(PG8_SB(1, 0), b3, voffB); PG8_STAGE(PG8_SB(1, 1), b3 + hstep, voffB); PG8_STAGE(PG8_SA(1, 0), a3, voffA);
            PG8_WAIT_V(8); PG8_WAIT_L(0); PG8_BAR; PG8_MMA(1, 0, At, B0); PG8_MMA(1, 1, At, B1); PG8_BAR; PG8_SCHED;
        }
        if (wr == 0) PG8_BAR;
        E(acc, cur, wr, wc, fr, fq, ldx, pre);
        if (!has_next) break;
#pragma unroll
        for (int a = 0; a < 2; ++a)
#pragma unroll
            for (int b = 0; b < 2; ++b)
#pragma unroll
                for (int m = 0; m < 4; ++m)
#pragma unroll
                    for (int n = 0; n < 2; ++n) acc[a][b][m][n] = (f32x4){0.f, 0.f, 0.f, 0.f};
        cur = nxt; cA = nA; cB = nB; ++ui;
        E.prefetch(pre, cur, wr, wc, fr, fq);
        if (wr == 1) PG8_BAR;
    }
    PG8_WAIT_V(0);
    PG8_BAR;
#undef PG8_SA
#undef PG8_SB
#undef PG8_STAGE
#undef PG8_LDA
#undef PG8_LDB
#undef PG8_MMA
#undef PG8_WAIT_V
#undef PG8_WAIT_L
#undef PG8_BAR
#undef PG8_SCHED
}
}

namespace att {
constexpr int KSTR = 144, K_BYTES = 64 * KSTR, V_HALF = 4160, V_BYTES = 2 * V_HALF, BUF_BYTES = K_BYTES + V_BYTES;
constexpr int RPB_OFF = 4 * BUF_BYTES + 1024;
typedef short v4i16_t __attribute__((ext_vector_type(4)));
__device__ __forceinline__ s16x4 vtr(const LAS unsigned char* p) { return __builtin_bit_cast(s16x4, __builtin_amdgcn_ds_read_tr16_b64_v4i16((LAS v4i16_t*)p)); }

template <int MASK, bool FIX>
__device__ __forceinline__ void half_step(const LAS unsigned char* buf, int kvoff, const bf16x8 (&qf)[4], f32x16& o0, f32x16& o1, float& m, float& l,
                                          int lane, int r32, int hi, const LAS float* rpbl, int bidx0, unsigned vmask, const f32x16& cinit) {
    const LAS unsigned char* kp = buf + (kvoff + r32) * KSTR + hi * 16;
    f32x16 s = cinit;
#pragma unroll
    for (int d0 = 0; d0 < 4; ++d0) { const bf16x8 kf = *(const LAS bf16x8*)(kp + d0 * 32); s = __builtin_amdgcn_mfma_f32_32x32x16_bf16(kf, qf[d0], s, 0, 0, 0); }
    const float NEG = -INFINITY;
    if (MASK == 3) {
        float bv[16];
#pragma unroll
        for (int r = 0; r < 16; ++r) bv[r] = rpbl[bidx0 + (r & 3) + 8 * (r >> 2)];
#pragma unroll
        for (int r = 0; r < 16; ++r) asm volatile("" : "+v"(bv[r]));
#pragma unroll
        for (int r = 0; r < 16; ++r) s[r] = ((vmask >> r) & 1u) ? (s[r] + bv[r]) : NEG;
    }
#pragma unroll
    for (int r = 0; r < 16; ++r) {
        const int kl0 = (r & 3) + 8 * (r >> 2);
        if (MASK == 1) { if (kl0 + 4 * hi < r32) s[r] = NEG; }
        if (MASK == 2) { if (kl0 + 4 * hi > r32) s[r] = NEG; }
    }
    if (!FIX) {
        float mx = fmaxf(fmaxf(s[0], s[1]), fmaxf(s[2], s[3]));
#pragma unroll
        for (int r = 4; r < 16; r += 4) mx = fmaxf(mx, fmaxf(fmaxf(s[r], s[r + 1]), fmaxf(s[r + 2], s[r + 3])));
        mx = swap_max(mx);
        const float mnew = fmaxf(m, mx);
        const float msafe = (mnew == NEG) ? 0.f : mnew;
        if (__any(mnew > m)) {
            const float alpha = __builtin_amdgcn_exp2f(m - msafe);
            l *= alpha;
#pragma unroll
            for (int r = 0; r < 16; ++r) { o0[r] *= alpha; o1[r] *= alpha; }
        }
        m = mnew;
        float ls = 0.f;
#pragma unroll
        for (int r = 0; r < 16; ++r) { s[r] = __builtin_amdgcn_exp2f(s[r] - msafe); ls += s[r]; }
        l += ls;
    } else {
#pragma unroll
        for (int r = 0; r < 16; ++r) s[r] = __builtin_amdgcn_exp2f(s[r]);
        l += (((s[0] + s[1]) + (s[2] + s[3])) + ((s[4] + s[5]) + (s[6] + s[7]))) + (((s[8] + s[9]) + (s[10] + s[11])) + ((s[12] + s[13]) + (s[14] + s[15])));
    }
    u32x4 pw0, pw1;
    pw0.x = cvtpk(s[0], s[1]); pw0.y = cvtpk(s[2], s[3]); pw0.z = cvtpk(s[4], s[5]); pw0.w = cvtpk(s[6], s[7]);
    pw1.x = cvtpk(s[8], s[9]); pw1.y = cvtpk(s[10], s[11]); pw1.z = cvtpk(s[12], s[13]); pw1.w = cvtpk(s[14], s[15]);
    const bf16x8 p0 = __builtin_bit_cast(bf16x8, pw0), p1 = __builtin_bit_cast(bf16x8, pw1);
    const LAS unsigned char* vp = buf + K_BYTES + (kvoff + 4 * hi + ((lane & 15) >> 2)) * 64 + 32 * ((lane >> 4) & 1) + 8 * (lane & 3);
#pragma unroll
    for (int dh = 0; dh < 2; ++dh) {
        const s16x4 a0 = vtr(vp + dh * V_HALF), a1 = vtr(vp + dh * V_HALF + 512), b0 = vtr(vp + dh * V_HALF + 1024), b1 = vtr(vp + dh * V_HALF + 1536);
        const bf16x8 vf0 = {a0[0], a0[1], a0[2], a0[3], a1[0], a1[1], a1[2], a1[3]};
        const bf16x8 vf1 = {b0[0], b0[1], b0[2], b0[3], b1[0], b1[1], b1[2], b1[3]};
        if (dh == 0) { o0 = __builtin_amdgcn_mfma_f32_32x32x16_bf16(vf0, p0, o0, 0, 0, 0); o0 = __builtin_amdgcn_mfma_f32_32x32x16_bf16(vf1, p1, o0, 0, 0, 0); }
        else         { o1 = __builtin_amdgcn_mfma_f32_32x32x16_bf16(vf0, p0, o1, 0, 0, 0); o1 = __builtin_amdgcn_mfma_f32_32x32x16_bf16(vf1, p1, o1, 0, 0, 0); }
    }
}

template <bool MASKED>
__device__ __forceinline__ void tile64(const LAS unsigned char* buf, const bf16x8 (&qf)[4], f32x16& o0, f32x16& o1, float& l, int lane, int r32, int hi, const f32x16& cinit,
                                       int a0, int b0, int a1, int b1) {
#define T64_SB() __builtin_amdgcn_sched_barrier(0)
    const LAS unsigned char* kp = buf + r32 * KSTR + hi * 16;
    const LAS unsigned char* vp = buf + K_BYTES + (4 * hi + ((lane & 15) >> 2)) * 64 + 32 * ((lane >> 4) & 1) + 8 * (lane & 3);
    const int dq = 4 * hi - r32; const float NEG = -INFINITY;
    bf16x8 kf0[4], kf1[4];
#pragma unroll
    for (int d0 = 0; d0 < 4; ++d0) { kf0[d0] = *(const LAS bf16x8*)(kp + d0 * 32); kf1[d0] = *(const LAS bf16x8*)(kp + 32 * KSTR + d0 * 32); }
    T64_SB();
    f32x16 s0 = cinit, s1 = cinit;
#pragma unroll
    for (int d0 = 0; d0 < 4; ++d0) s0 = __builtin_amdgcn_mfma_f32_32x32x16_bf16(kf0[d0], qf[d0], s0, 0, 0, 0);
    s16x4 va[2][8];
#pragma unroll
    for (int dh = 0; dh < 2; ++dh)
#pragma unroll
        for (int j = 0; j < 8; ++j) va[dh][j] = vtr(vp + dh * V_HALF + j * 512);
    T64_SB();
#pragma unroll
    for (int d0 = 0; d0 < 4; ++d0) {
        s1 = __builtin_amdgcn_mfma_f32_32x32x16_bf16(kf1[d0], qf[d0], s1, 0, 0, 0);
#pragma unroll
        for (int r = 4 * d0; r < 4 * d0 + 4; ++r) { if (MASKED) { const int t = (r & 3) + 8 * (r >> 2) + dq; if (t < a0 || t > b0) s0[r] = NEG; } s0[r] = __builtin_amdgcn_exp2f(s0[r]); }
        T64_SB();
    }
    u32x4 w00, w01;
    w00.x = cvtpk(s0[0], s0[1]); w00.y = cvtpk(s0[2], s0[3]); w00.z = cvtpk(s0[4], s0[5]); w00.w = cvtpk(s0[6], s0[7]);
    w01.x = cvtpk(s0[8], s0[9]); w01.y = cvtpk(s0[10], s0[11]); w01.z = cvtpk(s0[12], s0[13]); w01.w = cvtpk(s0[14], s0[15]);
    const bf16x8 p00 = __builtin_bit_cast(bf16x8, w00), p01 = __builtin_bit_cast(bf16x8, w01);
    l += (((s0[0] + s0[1]) + (s0[2] + s0[3])) + ((s0[4] + s0[5]) + (s0[6] + s0[7]))) + (((s0[8] + s0[9]) + (s0[10] + s0[11])) + ((s0[12] + s0[13]) + (s0[14] + s0[15])));
#define T64_VF(dh, j) (bf16x8){va[dh][2 * (j)][0], va[dh][2 * (j)][1], va[dh][2 * (j)][2], va[dh][2 * (j)][3], va[dh][2 * (j) + 1][0], va[dh][2 * (j) + 1][1], va[dh][2 * (j) + 1][2], va[dh][2 * (j) + 1][3]}
#define T64_EXP1(R0) do { _Pragma("unroll") for (int r = (R0); r < (R0) + 4; ++r) { if (MASKED) { const int t = (r & 3) + 8 * (r >> 2) + dq; if (t < a1 || t > b1) s1[r] = NEG; } s1[r] = __builtin_amdgcn_exp2f(s1[r]); } } while (0)
    T64_SB();
    o0 = __builtin_amdgcn_mfma_f32_32x32x16_bf16(T64_VF(0, 0), p00, o0, 0, 0, 0); T64_EXP1(0);  T64_SB();
    o1 = __builtin_amdgcn_mfma_f32_32x32x16_bf16(T64_VF(1, 0), p00, o1, 0, 0, 0); T64_EXP1(4);  T64_SB();
    o0 = __builtin_amdgcn_mfma_f32_32x32x16_bf16(T64_VF(0, 1), p01, o0, 0, 0, 0); T64_EXP1(8);  T64_SB();
    o1 = __builtin_amdgcn_mfma_f32_32x32x16_bf16(T64_VF(1, 1), p01, o1, 0, 0, 0); T64_EXP1(12); T64_SB();
    u32x4 w10, w11;
    w10.x = cvtpk(s1[0], s1[1]); w10.y = cvtpk(s1[2], s1[3]); w10.z = cvtpk(s1[4], s1[5]); w10.w = cvtpk(s1[6], s1[7]);
    w11.x = cvtpk(s1[8], s1[9]); w11.y = cvtpk(s1[10], s1[11]); w11.z = cvtpk(s1[12], s1[13]); w11.w = cvtpk(s1[14], s1[15]);
    const bf16x8 p10 = __builtin_bit_cast(bf16x8, w10), p11 = __builtin_bit_cast(bf16x8, w11);
    l += (((s1[0] + s1[1]) + (s1[2] + s1[3])) + ((s1[4] + s1[5]) + (s1[6] + s1[7]))) + (((s1[8] + s1[9]) + (s1[10] + s1[11])) + ((s1[12] + s1[13]) + (s1[14] + s1[15])));
    o0 = __builtin_amdgcn_mfma_f32_32x32x16_bf16(T64_VF(0, 2), p10, o0, 0, 0, 0);
    o1 = __builtin_amdgcn_mfma_f32_32x32x16_bf16(T64_VF(1, 2), p10, o1, 0, 0, 0);
    o0 = __builtin_amdgcn_mfma_f32_32x32x16_bf16(T64_VF(0, 3), p11, o0, 0, 0, 0);
    o1 = __builtin_amdgcn_mfma_f32_32x32x16_bf16(T64_VF(1, 3), p11, o1, 0, 0, 0);
#undef T64_VF
#undef T64_EXP1
#undef T64_SB
}

__device__ __forceinline__ int clampi(int v, int lo, int hi) { return v < lo ? lo : (v > hi ? hi : v); }

template <int MODE, bool FIX>
__device__ __forceinline__ void attn_unit(LAS unsigned char* lds, const bf16_t* __restrict__ QKV, bf16_t* __restrict__ O, float* ssq1, const float* __restrict__ sinkp,
                                          const float* __restrict__ rpb, int unit, int tid, int lane, int wid, const float Mb) {
    const int r32 = lane & 31, hi = lane >> 5;
    const int b = unit >> 7, rem = unit & 127;
    int head, qtok, qcol, kcol, vcol, ocol, NTL, lrow0;
    int s_sub = 0, tl0 = 0;
    int qrow = 0, qc = 0, kc0 = 0, kr_lo = 0, wa_lo = 0, wa_hi = 0, rs = 0;
    unsigned colmask = 0u;
    if (MODE == 0) {
        const int qblk = rem >> 1, kvh = rem & 1, q0 = qblk * 64;
        head = kvh * 4 + (wid >> 1); s_sub = wid & 1; qtok = q0 + 32 * s_sub + r32; qcol = head * 64; kcol = 512 + kvh * 64; vcol = 640 + kvh * 64; ocol = head * 64;
        tl0 = (2 - qblk) > 0 ? (2 - qblk) : 0; const int tl1 = (65 - qblk) < 4 ? (65 - qblk) : 4; NTL = tl1 - tl0 + 1; lrow0 = b * SEQ + q0 - 128 + 64 * tl0;
    } else {
        head = rem >> 4; const int r0 = 4 * (rem & 15), rp = wid >> 2, cgp = wid & 3;
        qrow = r0 + 2 * rp + (r32 >> 4); qc = 16 * cgp + (r32 & 15); qtok = qrow * 64 + qc; qcol = 768 + head * 64; kcol = 1280 + head * 64; vcol = 1792 + head * 64; ocol = 512 + head * 64;
        kr_lo = (r0 - 4) > 0 ? (r0 - 4) : 0; const int kr_hi = clampi(r0 - 1, 0, 56) + 7; NTL = kr_hi - kr_lo + 1; lrow0 = b * SEQ + kr_lo * 64;
        kc0 = clampi(16 * cgp - 8, 0, 32); const int cs = clampi(qc - 8, 0, 48);
        wa_lo = clampi(r0 + 2 * rp - 4, 0, 56); wa_hi = clampi(r0 + 2 * rp - 3, 0, 56) + 7; rs = clampi(qrow - 4, 0, 56);
#pragma unroll
        for (int r = 0; r < 16; ++r) { const int kc = kc0 + (r & 3) + 8 * (r >> 2) + 4 * hi; if ((unsigned)(kc - cs) < 16u) colmask |= (1u << r); }
        LAS float* rt = (LAS float*)(lds + RPB_OFF);
        if (tid < 465) rt[tid] = rpb[head * 465 + tid] * LOG2E;
    }
    const int NT = NTL + 4, crow0 = ML + b * CTXL;
    const LAS float* rpbl = (const LAS float*)(lds + RPB_OFF);
    bf16x8 qf[4];
    { const bf16_t* qp = QKV + (size_t)(b * SEQ + qtok) * INC + qcol + hi * 8;
#pragma unroll
      for (int d0 = 0; d0 < 4; ++d0) qf[d0] = *(const bf16x8*)(qp + d0 * 16); }
    float m = FIX ? Mb : -INFINITY, l = 0.f;
    const float ci = FIX ? -Mb : 0.f;
    const f32x16 cinit = {ci, ci, ci, ci, ci, ci, ci, ci, ci, ci, ci, ci, ci, ci, ci, ci};
    f32x16 o0 = {0.f, 0.f, 0.f, 0.f, 0.f, 0.f, 0.f, 0.f, 0.f, 0.f, 0.f, 0.f, 0.f, 0.f, 0.f, 0.f}, o1 = o0;
    const int srow = tid >> 3, sch = tid & 7;
    const bf16_t* gk = QKV + (size_t)srow * INC + kcol + sch * 8;
    const bf16_t* gv = QKV + (size_t)srow * INC + vcol + sch * 8;
    const unsigned kwoff = srow * KSTR + sch * 16, vwoff = K_BYTES + (sch >> 2) * V_HALF + srow * 64 + (sch & 3) * 16;
#define ATT_TROW(i) ((i) < NTL ? lrow0 + 64 * (i) : crow0 + 64 * ((i) - NTL))
#define ATT_LOAD(KR, VR, i) do { const size_t ro_ = (size_t)ATT_TROW(i) * INC; KR = *(const u32x4*)(gk + ro_); VR = *(const u32x4*)(gv + ro_); } while (0)
#define ATT_COMPUTE(i, buf) do { \
        if ((i) < NTL) { \
            if (MODE == 0) { \
                const int tl = tl0 + (i); \
                if (FIX) { \
                    const int dA = 2 * tl - s_sub, dB = dA + 1; \
                    if (dA >= 1 && dB <= 7) tile64<false>(buf, qf, o0, o1, l, lane, r32, hi, cinit, 0, 0, 0, 0); \
                    else { const int a0 = (dA < 0 || dA > 8) ? 99 : (dA == 0 ? 0 : -99), b0 = (dA < 0 || dA > 8) ? -99 : (dA == 8 ? 0 : 99); \
                           const int a1 = (dB < 0 || dB > 8) ? 99 : (dB == 0 ? 0 : -99), b1 = (dB < 0 || dB > 8) ? -99 : (dB == 8 ? 0 : 99); \
                           tile64<true>(buf, qf, o0, o1, l, lane, r32, hi, cinit, a0, b0, a1, b1); } \
                } else { \
                _Pragma("unroll") for (int hlf = 0; hlf < 2; ++hlf) { \
                    const int d = 2 * tl + hlf - s_sub; \
                    if (d == 0) half_step<1, FIX>(buf, 32 * hlf, qf, o0, o1, m, l, lane, r32, hi, rpbl, 0, 0u, cinit); \
                    else if (d == 8) half_step<2, FIX>(buf, 32 * hlf, qf, o0, o1, m, l, lane, r32, hi, rpbl, 0, 0u, cinit); \
                    else if (d > 0 && d < 8) half_step<0, FIX>(buf, 32 * hlf, qf, o0, o1, m, l, lane, r32, hi, rpbl, 0, 0u, cinit); \
                } } \
            } else { \
                const int kr = kr_lo + (i); \
                if (kr >= wa_lo && kr <= wa_hi) { \
                    const unsigned vm = ((unsigned)(kr - rs) < 8u) ? colmask : 0u; \
                    const int bidx0 = (kr - qrow + 7) * 31 + kc0 + 4 * hi - qc + 15; \
                    half_step<3, FIX>(buf, kc0, qf, o0, o1, m, l, lane, r32, hi, rpbl, bidx0, vm, cinit); \
                } \
            } \
        } else if (FIX) { \
            tile64<false>(buf, qf, o0, o1, l, lane, r32, hi, cinit, 0, 0, 0, 0); \
        } else { \
            half_step<0, FIX>(buf, 0, qf, o0, o1, m, l, lane, r32, hi, rpbl, 0, 0u, cinit); \
            half_step<0, FIX>(buf, 32, qf, o0, o1, m, l, lane, r32, hi, rpbl, 0, 0u, cinit); \
        } } while (0)
    if (FIX) {
        int nmask, nl1, tlu0;
        if (MODE == 0) { const int tl1 = tl0 + NTL - 1; nmask = (tl0 == 0 ? 1 : 0) + (tl1 == 4 ? 1 : 0); tlu0 = tl0 > 1 ? tl0 : 1; nl1 = (tl1 < 3 ? tl1 : 3) - tlu0 + 1; }
        else { nmask = NTL; nl1 = 0; tlu0 = 0; }
        const int lbase = (MODE == 0) ? (b * SEQ + 64 * (rem >> 1) - 128) : lrow0;
#define ATT_SEQ_TL(i) ((MODE == 0) ? (((i) == 0 && tl0 == 0) ? 0 : 4) : (i))
#define ATT_SEQ_ROW(i) ((i) < nmask ? lbase + 64 * ATT_SEQ_TL(i) : ((i) - nmask < nl1 ? lbase + 64 * (tlu0 + (i) - nmask) : crow0 + 64 * ((i) - nmask - nl1)))
#define ATT_STEP_PRE(i) \
            LAS unsigned char* buf = lds + ((i) & 1) * BUF_BYTES; \
            *(LAS u32x4*)(buf + kwoff) = kA; *(LAS u32x4*)(buf + vwoff) = vA; \
            asm volatile("s_waitcnt lgkmcnt(0)\n\ts_barrier" ::: "memory"); \
            { const int in_ = ((i) + 1 < NT) ? (i) + 1 : (i); const size_t ro_ = (size_t)ATT_SEQ_ROW(in_) * INC; kA = *(const u32x4*)(gk + ro_); vA = *(const u32x4*)(gv + ro_); }
        u32x4 kA, vA;
        { const size_t ro_ = (size_t)ATT_SEQ_ROW(0) * INC; kA = *(const u32x4*)(gk + ro_); vA = *(const u32x4*)(gv + ro_); }
        int i = 0;
        for (; i < nmask; ++i) {
            ATT_STEP_PRE(i)
            if (MODE == 0) {
                const int tl = ATT_SEQ_TL(i); const int dA = 2 * tl - s_sub, dB = dA + 1;
                const int a0 = (dA < 0 || dA > 8) ? 99 : (dA == 0 ? 0 : -99), b0 = (dA < 0 || dA > 8) ? -99 : (dA == 8 ? 0 : 99);
                const int a1 = (dB < 0 || dB > 8) ? 99 : (dB == 0 ? 0 : -99), b1 = (dB < 0 || dB > 8) ? -99 : (dB == 8 ? 0 : 99);
                if (dA < 0) half_step<1, true>(buf, 32, qf, o0, o1, m, l, lane, r32, hi, rpbl, 0, 0u, cinit);
                else if (dB > 8) half_step<2, true>(buf, 0, qf, o0, o1, m, l, lane, r32, hi, rpbl, 0, 0u, cinit);
                else tile64<true>(buf, qf, o0, o1, l, lane, r32, hi, cinit, a0, b0, a1, b1);
            } else {
                const int kr = kr_lo + i;
                if (kr >= wa_lo && kr <= wa_hi) {
                    const unsigned vm = ((unsigned)(kr - rs) < 8u) ? colmask : 0u;
                    const int bidx0 = (kr - qrow + 7) * 31 + kc0 + 4 * hi - qc + 15;
                    half_step<3, true>(buf, kc0, qf, o0, o1, m, l, lane, r32, hi, rpbl, bidx0, vm, cinit);
                }
            }
        }
        for (; i < NT; ++i) {
            ATT_STEP_PRE(i)
            tile64<false>(buf, qf, o0, o1, l, lane, r32, hi, cinit, 0, 0, 0, 0);
        }
#undef ATT_SEQ_TL
#undef ATT_SEQ_ROW
#undef ATT_STEP_PRE
    } else {
    u32x4 kA, vA, kB, vB;
    const int NP = (NT + 1) >> 1;
    ATT_LOAD(kA, vA, 0); ATT_LOAD(kB, vB, 1);
    for (int j = 0; j < NP; ++j) {
        LAS unsigned char* buf = lds + (j & 1) * (2 * BUF_BYTES);
        const int i0 = 2 * j; const bool two = (i0 + 1 < NT);
        *(LAS u32x4*)(buf + kwoff) = kA; *(LAS u32x4*)(buf + vwoff) = vA;
        if (two) { *(LAS u32x4*)(buf + BUF_BYTES + kwoff) = kB; *(LAS u32x4*)(buf + BUF_BYTES + vwoff) = vB; }
        asm volatile("s_waitcnt lgkmcnt(0)\n\ts_barrier" ::: "memory");
        if (i0 + 2 < NT) ATT_LOAD(kA, vA, i0 + 2);
        if (i0 + 3 < NT) ATT_LOAD(kB, vB, i0 + 3);
        ATT_COMPUTE(i0, buf);
        if (two) { const LAS unsigned char* buf2 = buf + BUF_BYTES; ATT_COMPUTE(i0 + 1, buf2); }
    }
    }
#undef ATT_LOAD
#undef ATT_COMPUTE
#undef ATT_TROW
    float lt = swap_sum(l);
    if (MODE == 0) lt += __builtin_amdgcn_exp2f(sinkp[head] * LOG2E - m);
    const float inv = 1.0f / lt;
    float ss = 0.f;
#pragma unroll
    for (int r = 0; r < 16; ++r) { o0[r] *= inv; o1[r] *= inv; ss += o0[r] * o0[r] + o1[r] * o1[r]; }
    ss = swap_sum(ss);
    const size_t orow = (size_t)(b * SEQ + qtok);
    if (hi == 0) atomicAdd(ssq1 + 2 * orow + MODE, ss);
    bf16_t* op = O + orow * DM + ocol + (hi ? 8 : 0);
#pragma unroll
    for (int j = 0; j < 2; ++j) {
        u32x2 a0, b0, a1, b1;
        a0.x = cvtpk(o0[8 * j], o0[8 * j + 1]); a0.y = cvtpk(o0[8 * j + 2], o0[8 * j + 3]); b0.x = cvtpk(o0[8 * j + 4], o0[8 * j + 5]); b0.y = cvtpk(o0[8 * j + 6], o0[8 * j + 7]);
        a1.x = cvtpk(o1[8 * j], o1[8 * j + 1]); a1.y = cvtpk(o1[8 * j + 2], o1[8 * j + 3]); b1.x = cvtpk(o1[8 * j + 4], o1[8 * j + 5]); b1.y = cvtpk(o1[8 * j + 6], o1[8 * j + 7]);
        auto x0 = __builtin_amdgcn_permlane32_swap(a0.x, b0.x, false, false); auto y0 = __builtin_amdgcn_permlane32_swap(a0.y, b0.y, false, false);
        auto x1 = __builtin_amdgcn_permlane32_swap(a1.x, b1.x, false, false); auto y1 = __builtin_amdgcn_permlane32_swap(a1.y, b1.y, false, false);
        u32x4 w0, w1; w0.x = x0[0]; w0.y = y0[0]; w0.z = x0[1]; w0.w = y0[1]; w1.x = x1[0]; w1.y = y1[0]; w1.z = x1[1]; w1.w = y1[1];
        *(u32x4*)(op + 16 * j) = w0; *(u32x4*)(op + 32 + 16 * j) = w1;
    }
    asm volatile("s_waitcnt lgkmcnt(0)\n\ts_barrier" ::: "memory");
}
}

template <int MODE>
__device__ __forceinline__ void transpose_item(const float* __restrict__ W, int K, int N, bf16_t* __restrict__ WT, LAS float* scr, int item, int lane, const float* __restrict__ ga, const float* __restrict__ gb) {
    const int nblk = N / 32, kb = item / nblk, nb = item % nblk, k0 = 64 * kb, n0 = 32 * nb;
#pragma unroll 8
    for (int i = 0; i < 32; ++i) { const int kk = 2 * i + (lane >> 5); float v = W[(size_t)(k0 + kk) * N + n0 + (lane & 31)];
        if (MODE == 1) { const int k = k0 + kk; v *= (k < 512) ? ga[k] : gb[k - 512]; }
        scr[kk * 33 + (lane & 31)] = v; }
    asm volatile("s_waitcnt lgkmcnt(0)" ::: "memory");
    const int c = lane & 7;
#pragma unroll
    for (int j = 0; j < 4; ++j) { const int n = (lane >> 3) + 8 * j; const LAS float* s = scr + (8 * c) * 33 + n;
        u32x4 o; o.x = cvtpk(s[0 * 33], s[1 * 33]); o.y = cvtpk(s[2 * 33], s[3 * 33]); o.z = cvtpk(s[4 * 33], s[5 * 33]); o.w = cvtpk(s[6 * 33], s[7 * 33]);
        const int nn = n0 + n; int drow = nn;
        if (MODE == 2) drow = 256 * (nn >> 7) + (nn & 127);
        if (MODE == 3) drow = 256 * (nn >> 7) + 128 + (nn & 127);
        *(u32x4*)(WT + (size_t)drow * K + k0 + 8 * c) = o; }
    asm volatile("s_waitcnt lgkmcnt(0)" ::: "memory");
}

struct Args { const float* in[21]; float* out; unsigned char* ws; int ph_lo, ph_hi; };

enum { I_X = 0, I_C, I_CTX, I_CCTX, I_WMOD, I_BMOD, I_N1G, I_WIN, I_QNA, I_KNA, I_SINK, I_QNB, I_KNB, I_RPB, I_ONA, I_ONB, I_WOUT, I_N2G, I_WGATE, I_WUP, I_WDOWN };

#define XB_TMO      128
#define XB_XCNT(j)  (256  + 64 * (j))
#define XB_XSUB(j)  (1280 + 64 * (j))
#define XB_XGEN(j)  (2304 + 64 * (j))
#define XB_TOP      3328
#define XB_TOPGEN   3392
#define XCD_BAR_WORDS 3456
#define XB_SPIN_CAP (1u << 18)
__device__ __forceinline__ unsigned xb_ld(unsigned* p)              { return __hip_atomic_load(p, __ATOMIC_RELAXED, __HIP_MEMORY_SCOPE_AGENT); }
__device__ __forceinline__ unsigned xb_add(unsigned* p, unsigned v) { return __hip_atomic_fetch_add(p, v, __ATOMIC_RELAXED, __HIP_MEMORY_SCOPE_AGENT); }
__device__ __forceinline__ unsigned xb_xcc_id() { return (unsigned)__builtin_amdgcn_s_getreg((3 << 11) | 20) & 0xFu; }
#define XB_SPIN(cond, bar) do { unsigned _sp = 0; while (cond) { __builtin_amdgcn_s_sleep(1); \
    if ((++_sp & 255u) == 0u) { if (xb_ld(&(bar)[XB_TMO])) break; if (_sp > XB_SPIN_CAP) { atomicAdd(&(bar)[XB_TMO], 1u); break; } } } } while (0)
__device__ __forceinline__ void xcd_barrier_complete(unsigned* bar, unsigned x, unsigned G, unsigned& nloc, unsigned& nx) {
    unsigned sum, cnt, mine, sp = 0u;
    for (;;) {
        sum = 0u; cnt = 0u; mine = 0u;
#pragma unroll
        for (unsigned j = 0; j < 16; ++j) { const unsigned c = xb_ld(&bar[XB_XCNT(j)]); sum += c; cnt += (c > 0u) ? 1u : 0u; mine = (j == x) ? c : mine; }
        if (sum == G) break;
        __builtin_amdgcn_s_sleep(1);
        if ((++sp & 255u) == 0u) { if (xb_ld(&bar[XB_TMO])) break; if (sp > XB_SPIN_CAP) { atomicAdd(&bar[XB_TMO], 1u); break; } }
    }
    nloc = mine > 0u ? mine : 1u; nx = cnt > 0u ? cnt : 1u;
}
__device__ __forceinline__ void xcd_barrier(unsigned* bar, unsigned x, volatile LAS unsigned* st, unsigned G, int tid) {
    asm volatile("s_waitcnt vmcnt(0)" ::: "memory");
    __syncthreads();
    if (tid == 0) {
        __builtin_amdgcn_s_waitcnt(0);
        unsigned nloc = st[0], nx = st[1];
        if (nloc == 0u) { xcd_barrier_complete(bar, x, G, nloc, nx); st[0] = nloc; st[1] = nx; }
        const unsigned old = xb_add(&bar[XB_XSUB(x)], 1u);
        const unsigned gen = old / nloc;
        if (old + 1u == (gen + 1u) * nloc) {
            __builtin_amdgcn_fence(__ATOMIC_RELEASE, "agent");
            asm volatile("s_waitcnt vmcnt(0)" ::: "memory");
            const unsigned og = xb_add(&bar[XB_TOP], 1u);
            const unsigned tg = og / nx;
            if (og + 1u == (tg + 1u) * nx) xb_add(&bar[XB_TOPGEN], 1u);
            else XB_SPIN(xb_ld(&bar[XB_TOPGEN]) == tg, bar);
            __builtin_amdgcn_fence(__ATOMIC_ACQUIRE, "agent");
            xb_add(&bar[XB_XGEN(x)], 1u);
            asm volatile("s_waitcnt vmcnt(0)" ::: "memory");
        } else {
            XB_SPIN(xb_ld(&bar[XB_XGEN(x)]) == gen, bar);
            __builtin_amdgcn_fence(__ATOMIC_ACQUIRE, "agent");
            asm volatile("s_waitcnt vmcnt(0)" ::: "memory");
        }
    }
    __syncthreads();
}
__device__ __forceinline__ void grp_barrier(unsigned* bar2, unsigned x, unsigned nloc, int tid) {
    asm volatile("s_waitcnt vmcnt(0)" ::: "memory");
    __syncthreads();
    if (tid == 0) {
        __builtin_amdgcn_s_waitcnt(0);
        const unsigned old = xb_add(&bar2[XB_XSUB(x)], 1u);
        const unsigned gen = old / nloc;
        if (old + 1u == (gen + 1u) * nloc) {
            __builtin_amdgcn_fence(__ATOMIC_ACQUIRE, "agent");
            xb_add(&bar2[XB_XGEN(x)], 1u);
            asm volatile("s_waitcnt vmcnt(0)" ::: "memory");
        } else {
            XB_SPIN(xb_ld(&bar2[XB_XGEN(x)]) == gen, bar2);
            __builtin_amdgcn_fence(__ATOMIC_ACQUIRE, "agent");
            asm volatile("s_waitcnt vmcnt(0)" ::: "memory");
        }
    }
    __syncthreads();
}
typedef const char __attribute__((address_space(4)))* kaptr_t;
__device__ __forceinline__ const float* ka_ptr(kaptr_t ka, int off) { unsigned long long p; asm volatile("s_load_dwordx2 %0, %1, %2\n\ts_waitcnt lgkmcnt(0)" : "=s"(p) : "s"(ka), "i"(off) : "memory");
    return (const float*)(const __attribute__((address_space(1))) float*)p; }
__device__ __forceinline__ int ka_int(kaptr_t ka, int off) { int v; asm volatile("s_load_dword %0, %1, %2\n\ts_waitcnt lgkmcnt(0)" : "=s"(v) : "s"(ka), "i"(off) : "memory"); return v; }

__global__ void __launch_bounds__(NWAVES * 64, 2) fwd_kernel(Args args_unused) {
    extern __shared__ __attribute__((aligned(16))) unsigned char lds_raw[];
    LAS unsigned char* lds = (LAS unsigned char*)lds_raw;
    const kaptr_t ka = (kaptr_t)__builtin_amdgcn_kernarg_segment_ptr();
#define ARGP(i) ka_ptr(ka, (i) * 8)
#define ARG_OUT() ((float*)ka_ptr(ka, 168))
#define ARG_WS() ((unsigned char*)ka_ptr(ka, 176))
    const int wave = __builtin_amdgcn_readfirstlane(threadIdx.x >> 6);
#define GET_LANE() int lane; asm volatile("v_mbcnt_lo_u32_b32 %0, -1, 0\n\tv_mbcnt_hi_u32_b32 %0, -1, %0" : "=v"(lane)); const int tid = wave * 64 + lane; (void)tid;
    const int G = gridDim.x; const int bx = blockIdx.x; const int vcu = (G % 8 == 0) ? (bx % 8) * (G / 8) + bx / 8 : bx;
    const int lo = ka_int(ka, 184), hi = ka_int(ka, 188);
    const int gw = vcu * NWAVES + wave, NGW = G * NWAVES;
    if (lo > 1000) cg::this_grid().sync();
    const unsigned xcc = xb_xcc_id();
    { GET_LANE(); if (tid < 4) ((volatile LAS unsigned*)(lds + LDSCTL_OFF))[tid] = 0u; __syncthreads();
      if (hi - lo > 1 && tid == 0) ((volatile LAS unsigned*)(lds + LDSCTL_OFF))[2] = xb_add((unsigned*)(ARG_WS() + WS_BAR) + XB_XCNT(xcc), 1u);
      __syncthreads(); }
#ifndef PH_MASK
#define PH_MASK 255
#endif
#define IN(k) (((PH_MASK >> (k)) & 1) && lo <= (k) && (k) < hi)
#ifndef DUP_MASK
#define DUP_MASK 0
#endif
#define NREP(k) ((((DUP_MASK) >> (k)) & 1) ? 2 : 1)
#define FIRST_OF_2(k) ((((DUP_MASK) >> (k)) & 1) && rep == 0)
#define SEAM(k) do { if (IN(k) && IN((k) + 1)) { GET_LANE(); xcd_barrier((unsigned*)(ARG_WS() + WS_BAR), xcc, (volatile LAS unsigned*)(lds + LDSCTL_OFF), (unsigned)G, tid); } } while (0)

    if (IN(0)) for (int rep = 0; rep < NREP(0); ++rep) {
        GET_LANE();
        unsigned char* const ws = ARG_WS();
        float* const mod = (float*)(ws + (FIRST_OF_2(0) ? WS_DUMMY : WS_MOD));
        LAS float* scr = (LAS float*)(lds + wave * 16384);
        constexpr int I_GEMV = 96 * 32, I_IN = 16 * 72, I_OUT = 16 * 32, I_G = 16 * 88, I_D = 44 * 32, I_ROPE = 16 + 4 + 1;
        constexpr int NITEMS = I_GEMV + I_IN + I_OUT + 2 * I_G + I_D + I_ROPE;
        for (int it = gw; it < NITEMS; it += NGW) {
            int r = it;
            if (r < I_GEMV) {
                const int cb = r % 96, kc = r / 96, col = cb * 64 + lane, k0 = kc * 32;
                const float* cin = ARGP(I_C); const float* cc = ARGP(I_CCTX);
                for (int idx = lane; idx < 9 * 32; idx += 64) { const int bb = idx >> 5, kk = idx & 31; const float v = (bb < 8) ? cin[bb * DM + k0 + kk] : cc[k0 + kk]; scr[idx] = v / (1.0f + __expf(-v)); }
                asm volatile("s_waitcnt lgkmcnt(0)" ::: "memory");
                float a0 = 0.f, a1 = 0.f, a2 = 0.f, a3 = 0.f, a4 = 0.f, a5 = 0.f, a6 = 0.f, a7 = 0.f, a8 = 0.f;
                const float* wp = ARGP(I_WMOD) + (size_t)k0 * NMOD + col;
#pragma unroll 16
                for (int kk = 0; kk < 32; ++kk) { const float w = wp[(size_t)kk * NMOD];
                    a0 += scr[kk] * w; a1 += scr[32 + kk] * w; a2 += scr[64 + kk] * w; a3 += scr[96 + kk] * w; a4 += scr[128 + kk] * w; a5 += scr[160 + kk] * w; a6 += scr[192 + kk] * w; a7 += scr[224 + kk] * w; a8 += scr[256 + kk] * w; }
                const float bm = (kc == 0) ? ARGP(I_BMOD)[col] : 0.f;
                atomicAdd(mod + 0 * NMOD + col, a0 + bm); atomicAdd(mod + 1 * NMOD + col, a1 + bm); atomicAdd(mod + 2 * NMOD + col, a2 + bm); atomicAdd(mod + 3 * NMOD + col, a3 + bm);
                atomicAdd(mod + 4 * NMOD + col, a4 + bm); atomicAdd(mod + 5 * NMOD + col, a5 + bm); atomicAdd(mod + 6 * NMOD + col, a6 + bm); atomicAdd(mod + 7 * NMOD + col, a7 + bm);
                atomicAdd(mod + 8 * NMOD + col, a8 + bm);
                asm volatile("s_waitcnt lgkmcnt(0)" ::: "memory");
                continue;
            }
            r -= I_GEMV;
            if (r < I_IN) { transpose_item<0>(ARGP(I_WIN), DM, INC, (bf16_t*)(ws + WS_WIN), scr, r, lane, nullptr, nullptr); continue; } r -= I_IN;
            if (r < I_OUT) { transpose_item<1>(ARGP(I_WOUT), DM, DM, (bf16_t*)(ws + WS_WOUT), scr, r, lane, ARGP(I_ONA), ARGP(I_ONB)); continue; } r -= I_OUT;
            if (r < I_G) { transpose_item<2>(ARGP(I_WGATE), DM, FFH, (bf16_t*)(ws + WS_WGU), scr, r, lane, nullptr, nullptr); continue; } r -= I_G;
            if (r < I_G) { transpose_item<3>(ARGP(I_WUP), DM, FFH, (bf16_t*)(ws + WS_WGU), scr, r, lane, nullptr, nullptr); continue; } r -= I_G;
            if (r < I_D) { transpose_item<0>(ARGP(I_WDOWN), FFH, DM, (bf16_t*)(ws + WS_WDN), scr, r, lane, nullptr, nullptr); continue; } r -= I_D;
            if (r == 20) {
                float ga = fabsf(ARGP(I_QNA)[lane]), gb = fabsf(ARGP(I_KNA)[lane]), gc = fabsf(ARGP(I_QNB)[lane]), gd = fabsf(ARGP(I_KNB)[lane]), rm = 0.f;
                const float* rp = ARGP(I_RPB);
                for (int idx = lane; idx < 8 * 465; idx += 64) rm = fmaxf(rm, fabsf(rp[idx]));
#pragma unroll
                for (int o = 1; o < 64; o <<= 1) { ga = fmaxf(ga, __shfl_xor(ga, o)); gb = fmaxf(gb, __shfl_xor(gb, o)); gc = fmaxf(gc, __shfl_xor(gc, o)); gd = fmaxf(gd, __shfl_xor(gd, o)); rm = fmaxf(rm, __shfl_xor(rm, o)); }
                if (lane == 0) { float* bd = (float*)(ws + WS_BOUNDS); bd[0] = 64.0f * C2 * ga * gb * 1.02f; bd[1] = 64.0f * C2 * gc * gd * 1.02f + rm * LOG2E; }
                continue; }
            if (r >= 16) { const int t = r - 16; float gvv; if (t == 0) gvv = ARGP(I_QNA)[lane]; else if (t == 1) gvv = ARGP(I_KNA)[lane]; else if (t == 2) gvv = ARGP(I_QNB)[lane]; else gvv = ARGP(I_KNB)[lane];
                ((float*)(ws + WS_GAINS))[t * 64 + lane] = gvv; continue; }
            { const int idx = r * 64 + lane, pos = idx >> 4, fi = idx & 15; const float inv = 1.0f / powf(10000.0f, (float)fi * (1.0f / 16.0f)); const float ang = (float)pos * inv;
              ((float*)(ws + WS_ROPE))[idx] = cosf(ang); ((float*)(ws + WS_ROPE))[1024 + idx] = sinf(ang); }
        }
    }
    SEAM(0);
    { GET_LANE();
      if (tid == 0) { unsigned ok = (hi - lo > 1 && G == 256) ? 1u : 0u; const unsigned* bw = (const unsigned*)(ARG_WS() + WS_BAR);
          for (unsigned j = 0; j < 16; ++j) { const unsigned c = xb_ld((unsigned*)&bw[XB_XCNT(j)]); if (c != (j < 8 ? (unsigned)(G >> 3) : 0u)) ok = 0u; }
          ((volatile LAS unsigned*)(lds + LDSCTL_OFF))[3] = ok; }
      __syncthreads(); }
    const bool grouped = __builtin_amdgcn_readfirstlane(((volatile LAS unsigned*)(lds + LDSCTL_OFF))[3]) != 0u;
    const int gx = grouped ? (int)xcc : (bx & 7), gl = grouped ? (int)__builtin_amdgcn_readfirstlane(((volatile LAS unsigned*)(lds + LDSCTL_OFF))[2]) : (bx >> 3);
    const int cv = gl * 8 + gx;
    const int vcu2 = grouped ? gx * (G >> 3) + gl : vcu;
#define GSEAM(k) do { if (IN(k) && IN((k) + 1)) { GET_LANE(); if (grouped) grp_barrier((unsigned*)(ARG_WS() + WS_BAR) + XCD_BAR_WORDS, (unsigned)gx, (unsigned)(G >> 3), tid); \
        else xcd_barrier((unsigned*)(ARG_WS() + WS_BAR), xcc, (volatile LAS unsigned*)(lds + LDSCTL_OFF), (unsigned)G, tid); } } while (0)

    if (IN(1)) for (int rep = 0; rep < NREP(1); ++rep) {
        GET_LANE();
        unsigned char* const ws = ARG_WS();
        const float* mod = (const float*)(ws + WS_MOD); bf16_t* Hb = (bf16_t*)(ws + WS_H);
        const float* x = ARGP(I_X); const float* ctx = ARGP(I_CTX); const float* ng = ARGP(I_N1G);
#define P1_ROW(mrow) do { \
            const float* xr = (mrow < ML) ? x + (size_t)mrow * DM : ctx + (size_t)(mrow - ML) * DM; \
            const float* mr = mod + (size_t)((mrow < ML) ? (mrow >> 12) : 8) * NMOD; \
            f32x4 v[4]; float s = 0.f; \
            _Pragma("unroll") \
            for (int j = 0; j < 4; ++j) { v[j] = *(const f32x4*)(xr + 512 * (j >> 1) + 8 * lane + 4 * (j & 1)); s += (v[j][0] * v[j][0] + v[j][1] * v[j][1]) + (v[j][2] * v[j][2] + v[j][3] * v[j][3]); } \
            const float rinv = rsqrtf(wave_sum(s) * (1.0f / DM) + EPS); \
            _Pragma("unroll") \
            for (int jj = 0; jj < 2; ++jj) { u32x4 w; \
            _Pragma("unroll") \
                for (int h = 0; h < 2; ++h) { const int col = 512 * jj + 8 * lane + 4 * h; const f32x4 g = *(const f32x4*)(ng + col), sh = *(const f32x4*)(mr + col), sc = *(const f32x4*)(mr + DM + col); \
                    const f32x4 o = (v[2 * jj + h] * rinv * g) * (sc + 1.0f) + sh; if (h == 0) { w.x = cvtpk(o[0], o[1]); w.y = cvtpk(o[2], o[3]); } else { w.z = cvtpk(o[0], o[1]); w.w = cvtpk(o[2], o[3]); } } \
                *(u32x4*)(Hb + (size_t)mrow * DM + 512 * jj + 8 * lane) = w; } \
        } while (0)
        { const int nrow = grouped ? (4 * SEQ + 4 * CTXL) : MT;
          for (int r = gw; r < nrow; r += NGW) { const int mrow = (!grouped || r < 4 * SEQ) ? r : ML + (r - 4 * SEQ); P1_ROW(mrow); } }
        { const bf16_t* Wgu = (const bf16_t*)(ws + WS_WGU); float* beta = (float*)(ws + WS_BETA);
          f32x4 sh[8][4];
#pragma unroll
          for (int bb = 0; bb < 8; ++bb)
#pragma unroll
              for (int q = 0; q < 4; ++q) sh[bb][q] = *(const f32x4*)(mod + (size_t)bb * NMOD + 3 * DM + lane * 16 + 4 * q);
          for (int it = gw; it < 2 * FFH; it += NGW) {
              const u32x4 wa = *(const u32x4*)(Wgu + (size_t)it * DM + lane * 16), wb = *(const u32x4*)(Wgu + (size_t)it * DM + lane * 16 + 8);
              f32x4 wf[4];
              wf[0] = (f32x4){__uint_as_float(wa[0] << 16), __uint_as_float(wa[0] & 0xffff0000u), __uint_as_float(wa[1] << 16), __uint_as_float(wa[1] & 0xffff0000u)};
              wf[1] = (f32x4){__uint_as_float(wa[2] << 16), __uint_as_float(wa[2] & 0xffff0000u), __uint_as_float(wa[3] << 16), __uint_as_float(wa[3] & 0xffff0000u)};
              wf[2] = (f32x4){__uint_as_float(wb[0] << 16), __uint_as_float(wb[0] & 0xffff0000u), __uint_as_float(wb[1] << 16), __uint_as_float(wb[1] & 0xffff0000u)};
              wf[3] = (f32x4){__uint_as_float(wb[2] << 16), __uint_as_float(wb[2] & 0xffff0000u), __uint_as_float(wb[3] << 16), __uint_as_float(wb[3] & 0xffff0000u)};
              float a[8];
#pragma unroll
              for (int bb = 0; bb < 8; ++bb) { f32x4 t = sh[bb][0] * wf[0] + sh[bb][1] * wf[1] + sh[bb][2] * wf[2] + sh[bb][3] * wf[3]; a[bb] = (t[0] + t[1]) + (t[2] + t[3]); }
              const bool c0 = lane & 1, c1 = lane & 2, c2 = lane & 4;
              float p[4], q2[2], r1;
#pragma unroll
              for (int i = 0; i < 4; ++i) { const float keep = c0 ? a[i + 4] : a[i], send = c0 ? a[i] : a[i + 4]; p[i] = keep + __shfl_xor(send, 1); }
#pragma unroll
              for (int i = 0; i < 2; ++i) { const float keep = c1 ? p[i + 2] : p[i], send = c1 ? p[i] : p[i + 2]; q2[i] = keep + __shfl_xor(send, 2); }
              { const float keep = c2 ? q2[1] : q2[0], send = c2 ? q2[0] : q2[1]; r1 = keep + __shfl_xor(send, 4); }
              r1 += __shfl_xor(r1, 8); r1 += __shfl_xor(r1, 16); r1 += __shfl_xor(r1, 32);
              if (lane < 8) { const int bb = 4 * (lane & 1) + 2 * ((lane >> 1) & 1) + ((lane >> 2) & 1); beta[(size_t)bb * (2 * FFH) + it] = r1; }
          } }
    }
    SEAM(1);
    if (IN(1) && IN(2) && grouped && gx >= 4) {
        GET_LANE();
        unsigned char* const ws = ARG_WS();
        const float* mod = (const float*)(ws + WS_MOD); bf16_t* Hb = (bf16_t*)(ws + WS_H);
        const float* x = ARGP(I_X); const float* ctx = ARGP(I_CTX); const float* ng = ARGP(I_N1G);
        const int nlw = (G >> 3) * NWAVES;
        for (int r = gl * NWAVES + wave; r < SEQ + CTXL; r += nlw) { const int mrow = (r < SEQ) ? gx * SEQ + r : ML + gx * CTXL + (r - SEQ); P1_ROW(mrow); }
        grp_barrier((unsigned*)(ARG_WS() + WS_BAR) + XCD_BAR_WORDS, (unsigned)gx, (unsigned)(G >> 3), tid);
    }
#undef P1_ROW

    if (IN(2)) for (int rep = 0; rep < NREP(2); ++rep) {
        unsigned char* const ws = ARG_WS();
        pg8::Gemm g{(const bf16_t*)(ws + WS_H), (const bf16_t*)(ws + WS_WIN), MT, INC, DM};
        pg8::EpiInProj E{(bf16_t*)(ws + WS_QKV), (const float*)(ws + WS_GAINS), (const float*)(ws + WS_ROPE), (const float*)(ws + WS_ROPE) + 1024};
        if (grouped) { pg8::BatchOrder S{gx, gl, G >> 3}; pg8::gemm_phase<pg8::EpiInProj, pg8::BatchOrder>(lds, lds + LDX_OFF, g, S, E, wave); }
        else { pg8::StaticOrder S; S.init(MT, INC, G, bx); pg8::gemm_phase<pg8::EpiInProj, pg8::StaticOrder>(lds, lds + LDX_OFF, g, S, E, wave); }
    }
    GSEAM(2);

    if (IN(3)) for (int rep = 0; rep < NREP(3); ++rep) {
        GET_LANE();
        unsigned char* const ws = ARG_WS();
        const bf16_t* QKV = (const bf16_t*)(ws + WS_QKV); bf16_t* Ob = (bf16_t*)(ws + WS_O); float* ssq1 = (float*)(ws + (FIRST_OF_2(3) ? WS_DUMMY : WS_SSQ1));
        const float* sinkp = ARGP(I_SINK); const float* rpbp = ARGP(I_RPB);
        const int per = (1024 + G - 1) / G;
        if (wave >= 4) __builtin_amdgcn_s_setprio(1);
        const float MA = ((const float*)(ws + WS_BOUNDS))[0], MB = ((const float*)(ws + WS_BOUNDS))[1];
        const bool fixA = MA < 48.0f, fixB = MB < 48.0f;
        for (int i = 0; i < per; ++i) { const int ua = vcu2 * per + i; if (ua < 1024) { if (fixA) att::attn_unit<0, true>(lds, QKV, Ob, ssq1, sinkp, rpbp, ua, tid, lane, wave, MA); else att::attn_unit<0, false>(lds, QKV, Ob, ssq1, sinkp, rpbp, ua, tid, lane, wave, 0.f); } }
        for (int i = 0; i < per; ++i) { const int ub = (G == 256) ? ((vcu2 >> 5) * 128 + i * 32 + (vcu2 & 31)) : (vcu2 * per + i);
            if (ub < 1024) { if (fixB) att::attn_unit<1, true>(lds, QKV, Ob, ssq1, sinkp, rpbp, ub, tid, lane, wave, MB); else att::attn_unit<1, false>(lds, QKV, Ob, ssq1, sinkp, rpbp, ub, tid, lane, wave, 0.f); } }
    }
    __builtin_amdgcn_s_setprio(0);
    GSEAM(3);

    if (IN(4)) for (int rep = 0; rep < NREP(4); ++rep) {
        unsigned char* const ws = ARG_WS();
        pg8::Gemm g{(const bf16_t*)(ws + WS_O), (const bf16_t*)(ws + WS_WOUT), ML, DM, DM}; pg8::StaticOrder S; S.init(ML, DM, G, cv);
        pg8::EpiOutProj E{ARGP(I_X), (bf16_t*)(ws + WS_QKV), (const float*)(ws + WS_SSQ1), (float*)(ws + (FIRST_OF_2(4) ? WS_DUMMY : WS_SSQ2)), (const float*)(ws + WS_MOD), (bf16_t*)(ws + WS_H), ARGP(I_N2G)};
        pg8::gemm_phase<pg8::EpiOutProj, pg8::StaticOrder>(lds, lds + LDX_OFF, g, S, E, wave);
    }
    GSEAM(4);

    if (IN(6)) for (int rep = 0; rep < NREP(6); ++rep) {
        unsigned char* const ws = ARG_WS();
        pg8::Gemm g{(const bf16_t*)(ws + WS_H), (const bf16_t*)(ws + WS_WGU), ML, 2 * FFH, DM}; pg8::StaticOrder S; S.init(ML, 2 * FFH, G, cv);
        pg8::EpiGateUp E{(bf16_t*)(ws + WS_HID), (const float*)(ws + WS_SSQ2), (const float*)(ws + WS_BETA)};
        pg8::gemm_phase<pg8::EpiGateUp, pg8::StaticOrder>(lds, lds + LDX_OFF, g, S, E, wave);
    }
    GSEAM(6);

    if (IN(7)) for (int rep = 0; rep < NREP(7); ++rep) {
        unsigned char* const ws = ARG_WS();
        pg8::Gemm g{(const bf16_t*)(ws + WS_HID), (const bf16_t*)(ws + WS_WDN), ML, DM, FFH}; pg8::StaticOrder S; S.init(ML, DM, G, cv);
        pg8::EpiDown E{(const bf16_t*)(ws + WS_QKV), FIRST_OF_2(7) ? (float*)(ws + WS_O) : ARG_OUT(), (const float*)(ws + WS_MOD)};
        pg8::gemm_phase<pg8::EpiDown, pg8::StaticOrder>(lds, lds + LDX_OFF, g, S, E, wave);
    }
#undef IN
#undef SEAM
#undef ARGP
#undef ARG_OUT
#undef ARG_WS
#undef GET_LANE
}

extern "C" void kernel_launch(void* const* d_in, const int* in_sizes, int n_in, void* d_out, int out_size, void* d_ws, size_t ws_size, hipStream_t stream) {
    static int grid = 0;
    if (grid == 0) {
        if (n_in != 21 || in_sizes[0] != ML * DM || out_size != ML * DM || ws_size < WS_END) { fprintf(stderr, "kernel_launch: unexpected shapes (n_in %d in0 %d out %d ws %zu)\n", n_in, n_in > 0 ? in_sizes[0] : -1, out_size, ws_size); grid = -1; return; }
        int dev = 0, cus = 0, per_cu = 0;
        hipGetDevice(&dev); hipDeviceGetAttribute(&cus, hipDeviceAttributeMultiprocessorCount, dev);
        hipFuncSetAttribute((const void*)fwd_kernel, hipFuncAttributeMaxDynamicSharedMemorySize, LDS_BYTES);
        if (hipOccupancyMaxActiveBlocksPerMultiprocessor(&per_cu, (const void*)fwd_kernel, NWAVES * 64, LDS_BYTES) != hipSuccess || per_cu < 1) { fprintf(stderr, "kernel_launch: occupancy query says %d\n", per_cu); per_cu = 1; }
        (void)hipGetLastError();
        grid = cus;
    }
    if (grid < 0) return;
    hipMemsetAsync((char*)d_ws, 0, WS_ZERO_BYTES, stream);
    Args a{};
    for (int i = 0; i < 21; ++i) a.in[i] = (const float*)d_in[i];
    a.out = (float*)d_out; a.ws = (unsigned char*)d_ws;
#if MK_N_LAUNCHES == 1
    a.ph_lo = 0; a.ph_hi = 8;
    void* kargs[] = {&a};
    hipError_t e = hipLaunchCooperativeKernel((const void*)fwd_kernel, dim3(grid), dim3(NWAVES * 64), kargs, LDS_BYTES, stream);
    if (e != hipSuccess) fprintf(stderr, "cooperative launch failed: %s (grid %d)\n", hipGetErrorString(e), grid);
#else
    for (int p = 0; p < 8; ++p) { a.ph_lo = p; a.ph_hi = p + 1; hipLaunchKernelGGL(fwd_kernel, dim3(grid), dim3(NWAVES * 64), LDS_BYTES, stream, a); }
#endif
}
```
